# Optimizing an MI355X kernel written in HIP

```python
import math
import jax
import jax.numpy as jnp
from jax import lax
import numpy as np

D_MODEL = 1024
BATCH = 32
SEQ = 256
DEPTH = 2
DEC_BATCH = 2
DEC_SEQ = 4096
PAST_LEN = 512

GRID_W = 64
MIX_W = 1024
GROUP_W = 256
DIFF_HEADS = 4
DIFF_QK = 32
DIFF_V = 64
DIFF_REP = 2
FNET_GROUPS = 4
FNET_CH = 64
MLA_HEADS = 4
MLA_Q_RANK = 192
MLA_KV_RANK = 128
MLA_NOPE = 64
MLA_ROPE = 32
MLA_V = 64
GQA_HEADS = 4
GQA_KV_HEADS = 2
GQA_DIM = 64
GQA_REP = GQA_HEADS // GQA_KV_HEADS
D_FF = 4 * D_MODEL
N_MOD = 6
Q_BLOCK = 128
ROPE_THETA = 10000.0
EPS = 1e-6
DIFF_SCALE = DIFF_QK ** -0.5
MLA_SCALE = (MLA_NOPE + MLA_ROPE) ** -0.5
GQA_SCALE = GQA_DIM ** -0.5
SPLITS = (DIFF_HEADS * 2 * DIFF_QK, DIFF_HEADS * 2 * DIFF_QK, DIFF_HEADS * DIFF_V,
          FNET_GROUPS * FNET_CH, MLA_Q_RANK, MLA_KV_RANK, MLA_ROPE,
          GQA_HEADS * GQA_DIM, GQA_KV_HEADS * GQA_DIM, GQA_KV_HEADS * GQA_DIM)
IN_W = 1888

kernel_name = "hybrid_diffusion_parallel_groups_step"


def rmsnorm(x, g):
    xf = x.astype(jnp.float32)
    y = xf * lax.rsqrt(jnp.mean(xf * xf, axis=-1, keepdims=True) + EPS)
    return (y * g.astype(jnp.float32)).astype(x.dtype)


def adaln(c, w, b):
    mods = jax.nn.silu(c) @ w + b
    return jnp.split(mods, N_MOD, axis=-1)


def modulate(x, g, shift, scale):
    return rmsnorm(x, g) * (1.0 + scale) + shift


def rope_2d(x, row, col):
    d = x.shape[-1]
    a = d // 2
    inv = ROPE_THETA ** (-jnp.arange(0, a, 2, dtype=jnp.float32) / a)

    def rot(xa, pos):
        ang = pos.astype(jnp.float32)[:, None] * inv[None, :]
        cos = jnp.cos(ang)[None, :, None, :]
        sin = jnp.sin(ang)[None, :, None, :]
        x1 = xa[..., : a // 2].astype(jnp.float32)
        x2 = xa[..., a // 2:].astype(jnp.float32)
        return jnp.concatenate([x1 * cos - x2 * sin, x1 * sin + x2 * cos], axis=-1)

    out = jnp.concatenate([rot(x[..., :a], row), rot(x[..., a:], col)], axis=-1)
    return out.astype(x.dtype)


def blocked_attention(parts, scale):
    b, s, h, _ = parts[0][0].shape
    dv = parts[0][2].shape[-1]
    nb = s // Q_BLOCK
    q_blocks = tuple(jnp.moveaxis(q.reshape(b, nb, Q_BLOCK, h, q.shape[-1]), 1, 0) for q, _, _ in parts)
    keys = [k for _, k, _ in parts]
    vals = [v for _, _, v in parts]
    sizes = [k.shape[1] for k in keys]

    def one_block(qb):
        logits = jnp.concatenate(
            [jnp.einsum("bqhd,bkhd->bhqk", q_i, k_i, preferred_element_type=jnp.float32)
             for q_i, k_i in zip(qb, keys)], axis=-1) * scale
        probs = jax.nn.softmax(logits, axis=-1)
        out = None
        start = 0
        for v_i, n_i in zip(vals, sizes):
            o_i = jnp.einsum("bhqk,bkhd->bqhd", probs[..., start:start + n_i].astype(v_i.dtype), v_i)
            out = o_i if out is None else out + o_i
            start += n_i
        return out

    o = lax.map(one_block, q_blocks)
    return jnp.moveaxis(o, 0, 1).reshape(b, s, h, dv)


def split_cols(z):
    offs = []
    acc = 0
    for n in SPLITS[:-1]:
        acc += n
        offs.append(acc)
    return jnp.split(z, offs, axis=-1)


def mixer_inputs(h, lp):
    b, s, _ = h.shape
    a_q, a_k, a_v, b_u, c_q, c_kv, c_kr, d_q, d_k, d_v = split_cols(h @ lp["w_in"])
    q_mla = (rmsnorm(c_q, lp["mla_q_norm_g"]) @ lp["mla_w_uq"]).reshape(b, s, MLA_HEADS, MLA_NOPE + MLA_ROPE)
    return {
        "diff_q": a_q.reshape(b, s, DIFF_HEADS * 2, DIFF_QK),
        "diff_k": a_k.reshape(b, s, DIFF_HEADS, 2 * DIFF_QK),
        "diff_v": a_v.reshape(b, s, DIFF_HEADS, DIFF_V),
        "fnet_u": b_u,
        "mla_q_nope": q_mla[..., :MLA_NOPE],
        "mla_q_rope": q_mla[..., MLA_NOPE:],
        "mla_ckv": rmsnorm(c_kv, lp["mla_kv_norm_g"]),
        "mla_krope": c_kr,
        "gqa_q": rmsnorm(d_q.reshape(b, s, GQA_HEADS, GQA_DIM), lp["gqa_q_norm_g"]),
        "gqa_k": rmsnorm(d_k.reshape(b, s, GQA_KV_HEADS, GQA_DIM), lp["gqa_k_norm_g"]),
        "gqa_v": d_v.reshape(b, s, GQA_KV_HEADS, GQA_DIM),
    }


def diff_maps(k):
    b, s = k.shape[:2]
    return k.reshape(b, s, DIFF_HEADS * 2, DIFF_QK)


def mla_expand(ckv, w_ukv):
    b, s = ckv.shape[:2]
    kv = (ckv @ w_ukv).reshape(b, s, MLA_HEADS, MLA_NOPE + MLA_V)
    return kv[..., :MLA_NOPE], kv[..., MLA_NOPE:]


def bcast_heads(kr):
    return jnp.broadcast_to(kr, kr.shape[:2] + (MLA_HEADS, kr.shape[-1]))


def fourier_mix(u):
    b, s, _ = u.shape
    uf = u.astype(jnp.float32).reshape(b, s, FNET_GROUPS, FNET_CH)
    y = jnp.fft.fft2(uf, axes=(1, 3), norm="ortho").real
    return y.reshape(b, s, GROUP_W).astype(u.dtype)


def diff_combine(o, lam, g, lam_init):
    b, s = o.shape[:2]
    o = o.reshape(b, s, DIFF_HEADS, 2, DIFF_V)
    y = o[..., 0, :] - lam.astype(o.dtype) * o[..., 1, :]
    y = rmsnorm(y, g) * (1.0 - lam_init)
    return y.reshape(b, s, GROUP_W)


def mixer_output(o_diff, u, o_mla, o_gqa, lp, lam, lam_init):
    b, s = u.shape[:2]
    y = jnp.concatenate([
        diff_combine(o_diff, lam, lp["diff_subln_g"], lam_init),
        fourier_mix(u),
        o_mla.reshape(b, s, MLA_HEADS * MLA_V),
        o_gqa.reshape(b, s, GQA_HEADS * GQA_DIM)], axis=-1)
    return y @ lp["w_out"]


def sqrelu_mlp(h, lp):
    return jnp.square(jax.nn.relu(h @ lp["mlp_w1"])) @ lp["mlp_w2"]


def context_layer(x, mod, lp, lam, lam_init):
    sh1, sc1, g1, sh2, sc2, g2 = mod
    t = mixer_inputs(modulate(x, lp["norm_mix_g"], sh1, sc1), lp)
    o_a = blocked_attention([(t["diff_q"], diff_maps(t["diff_k"]), jnp.repeat(t["diff_v"], DIFF_REP, axis=2))], DIFF_SCALE)
    k_nope, v_mla = mla_expand(t["mla_ckv"], lp["mla_w_ukv"])
    q_mla = jnp.concatenate([t["mla_q_nope"], t["mla_q_rope"]], axis=-1)
    k_mla = jnp.concatenate([k_nope, bcast_heads(t["mla_krope"][:, :, None, :])], axis=-1)
    o_c = blocked_attention([(q_mla, k_mla, v_mla)], MLA_SCALE)
    o_d = blocked_attention([(t["gqa_q"], jnp.repeat(t["gqa_k"], GQA_REP, axis=2),
                              jnp.repeat(t["gqa_v"], GQA_REP, axis=2))], GQA_SCALE)
    x = x + g1 * mixer_output(o_a, t["fnet_u"], o_c, o_d, lp, lam, lam_init)
    x = x + g2 * sqrelu_mlp(modulate(x, lp["norm_mlp_g"], sh2, sc2), lp)
    state = (t["diff_k"], t["diff_v"], t["mla_ckv"], t["mla_krope"], t["gqa_k"], t["gqa_v"])
    return x, state


def latent_layer(x, mod, cache, lp, lam, lam_init, row, col):
    sh1, sc1, g1, sh2, sc2, g2 = mod
    ck_diff, cv_diff, c_ckv, c_kr, ck_gqa, cv_gqa = cache
    t = mixer_inputs(modulate(x, lp["norm_mix_g"], sh1, sc1), lp)
    o_a = blocked_attention([
        (rope_2d(t["diff_q"], row, col), rope_2d(diff_maps(t["diff_k"]), row, col),
         jnp.repeat(t["diff_v"], DIFF_REP, axis=2)),
        (t["diff_q"], diff_maps(ck_diff), jnp.repeat(cv_diff, DIFF_REP, axis=2))], DIFF_SCALE)
    k_nope, v_mla = mla_expand(t["mla_ckv"], lp["mla_w_ukv"])
    k_nope_c, v_mla_c = mla_expand(c_ckv, lp["mla_w_ukv"])
    q_rot = jnp.concatenate([t["mla_q_nope"], rope_2d(t["mla_q_rope"], row, col)], axis=-1)
    q_plain = jnp.concatenate([t["mla_q_nope"], t["mla_q_rope"]], axis=-1)
    k_lat = jnp.concatenate([k_nope, bcast_heads(rope_2d(t["mla_krope"][:, :, None, :], row, col))], axis=-1)
    k_ctx = jnp.concatenate([k_nope_c, bcast_heads(c_kr[:, :, None, :])], axis=-1)
    o_c = blocked_attention([(q_rot, k_lat, v_mla), (q_plain, k_ctx, v_mla_c)], MLA_SCALE)
    o_d = blocked_attention([
        (rope_2d(t["gqa_q"], row, col), jnp.repeat(rope_2d(t["gqa_k"], row, col), GQA_REP, axis=2),
         jnp.repeat(t["gqa_v"], GQA_REP, axis=2)),
        (t["gqa_q"], jnp.repeat(ck_gqa, GQA_REP, axis=2), jnp.repeat(cv_gqa, GQA_REP, axis=2))], GQA_SCALE)
    x = x + g1 * mixer_output(o_a, t["fnet_u"], o_c, o_d, lp, lam, lam_init)
    x = x + g2 * sqrelu_mlp(modulate(x, lp["norm_mlp_g"], sh2, sc2), lp)
    return x


def setup_inputs(seed: int = 0) -> dict:
    key = jax.random.key(seed)
    ks = jax.random.split(key, 32)
    f32 = jnp.float32

    def nrm(k, shape, scale=1.0):
        return jax.random.normal(k, shape, f32) * scale

    def gain(k, shape):
        return 1.0 + 0.05 * jax.random.normal(k, shape, f32)

    return {
        "x_prompt": nrm(ks[0], (BATCH, SEQ, D_MODEL)),
        "x_sample": nrm(ks[1], (DEC_BATCH, DEC_SEQ, D_MODEL)),
        "cache_diff_k": nrm(ks[2], (DEC_BATCH, DEPTH, PAST_LEN, DIFF_HEADS, 2 * DIFF_QK)),
        "cache_diff_v": nrm(ks[3], (DEC_BATCH, DEPTH, PAST_LEN, DIFF_HEADS, DIFF_V)),
        "cache_mla_ckv": nrm(ks[4], (DEC_BATCH, DEPTH, PAST_LEN, MLA_KV_RANK)),
        "cache_mla_krope": nrm(ks[5], (DEC_BATCH, DEPTH, PAST_LEN, MLA_ROPE)),
        "cache_gqa_k": nrm(ks[6], (DEC_BATCH, DEPTH, PAST_LEN, GQA_KV_HEADS, GQA_DIM)),
        "cache_gqa_v": nrm(ks[7], (DEC_BATCH, DEPTH, PAST_LEN, GQA_KV_HEADS, GQA_DIM)),
        "c": nrm(ks[8], (DEC_BATCH, D_MODEL)),
        "c_ctx": nrm(ks[9], (D_MODEL,)),
        "norm_mix_g": gain(ks[10], (DEPTH, D_MODEL)),
        "norm_mlp_g": gain(ks[11], (DEPTH, D_MODEL)),
        "ada_w": nrm(ks[12], (DEPTH, D_MODEL, N_MOD * D_MODEL), D_MODEL ** -0.5),
        "ada_b": nrm(ks[13], (DEPTH, N_MOD * D_MODEL), 0.02),
        "w_in": nrm(ks[14], (DEPTH, D_MODEL, IN_W), D_MODEL ** -0.5),
        "diff_lambda": nrm(ks[15], (DEPTH, 4, DIFF_QK), 0.1),
        "diff_subln_g": gain(ks[16], (DEPTH, DIFF_V)),
        "mla_q_norm_g": gain(ks[17], (DEPTH, MLA_Q_RANK)),
        "mla_w_uq": nrm(ks[18], (DEPTH, MLA_Q_RANK, MLA_HEADS * (MLA_NOPE + MLA_ROPE)), MLA_Q_RANK ** -0.5),
        "mla_kv_norm_g": gain(ks[19], (DEPTH, MLA_KV_RANK)),
        "mla_w_ukv": nrm(ks[20], (DEPTH, MLA_KV_RANK, MLA_HEADS * (MLA_NOPE + MLA_V)), MLA_KV_RANK ** -0.5),
        "gqa_q_norm_g": gain(ks[21], (DEPTH, GQA_DIM)),
        "gqa_k_norm_g": gain(ks[22], (DEPTH, GQA_DIM)),
        "w_out": nrm(ks[23], (DEPTH, MIX_W, D_MODEL), MIX_W ** -0.5),
        "mlp_w1": nrm(ks[24], (DEPTH, D_MODEL, D_FF), D_MODEL ** -0.5),
        "mlp_w2": nrm(ks[25], (DEPTH, D_FF, D_MODEL), D_FF ** -0.5),
        "final_norm_g": gain(ks[26], (D_MODEL,)),
    }


def reference(x_prompt, x_sample, cache_diff_k, cache_diff_v, cache_mla_ckv, cache_mla_krope,
              cache_gqa_k, cache_gqa_v, c, c_ctx, norm_mix_g, norm_mlp_g, ada_w, ada_b, w_in,
              diff_lambda, diff_subln_g, mla_q_norm_g, mla_w_uq, mla_kv_norm_g, mla_w_ukv,
              gqa_q_norm_g, gqa_k_norm_g, w_out, mlp_w1, mlp_w2, final_norm_g):
    n_lat = x_sample.shape[1]
    rows = n_lat // GRID_W
    row = jnp.repeat(jnp.arange(rows, dtype=jnp.int32), GRID_W)
    col = jnp.tile(jnp.arange(GRID_W, dtype=jnp.int32), rows)

    xp = x_prompt
    xs = x_sample
    st_diff_k, st_diff_v, st_ckv, st_kr, st_gk, st_gv = [], [], [], [], [], []
    for l in range(DEPTH):
        lp = {
            "norm_mix_g": norm_mix_g[l], "norm_mlp_g": norm_mlp_g[l], "w_in": w_in[l],
            "diff_subln_g": diff_subln_g[l], "mla_q_norm_g": mla_q_norm_g[l], "mla_w_uq": mla_w_uq[l],
            "mla_kv_norm_g": mla_kv_norm_g[l], "mla_w_ukv": mla_w_ukv[l],
            "gqa_q_norm_g": gqa_q_norm_g[l], "gqa_k_norm_g": gqa_k_norm_g[l],
            "w_out": w_out[l], "mlp_w1": mlp_w1[l], "mlp_w2": mlp_w2[l],
        }
        lam_init = 0.8 - 0.6 * math.exp(-0.3 * l)
        lamp = diff_lambda[l].astype(jnp.float32)
        lam = jnp.exp(jnp.sum(lamp[0] * lamp[1])) - jnp.exp(jnp.sum(lamp[2] * lamp[3])) + lam_init
        mod_ctx = adaln(c_ctx[None, None, :], ada_w[l], ada_b[l])
        mod_lat = adaln(c[:, None, :], ada_w[l], ada_b[l])

        xp, st = context_layer(xp, mod_ctx, lp, lam, lam_init)
        st_diff_k.append(st[0]); st_diff_v.append(st[1]); st_ckv.append(st[2])
        st_kr.append(st[3]); st_gk.append(st[4]); st_gv.append(st[5])

        cache_l = (cache_diff_k[:, l], cache_diff_v[:, l], cache_mla_ckv[:, l], cache_mla_krope[:, l],
                   cache_gqa_k[:, l], cache_gqa_v[:, l])
        xs = latent_layer(xs, mod_lat, cache_l, lp, lam, lam_init, row, col)

    y_prompt = rmsnorm(xp, final_norm_g)
    y_sample = rmsnorm(xs, final_norm_g)
    new_diff_k = jnp.stack(st_diff_k, axis=1)
    new_diff_v = jnp.stack(st_diff_v, axis=1)
    new_mla_ckv = jnp.stack(st_ckv, axis=1)
    new_mla_krope = jnp.stack(st_kr, axis=1)
    new_gqa_k = jnp.stack(st_gk, axis=1)
    new_gqa_v = jnp.stack(st_gv, axis=1)
    return (y_prompt, y_sample, new_diff_k, new_diff_v, new_mla_ckv, new_mla_krope, new_gqa_k, new_gqa_v)
```

```cpp
#include <hip/hip_runtime.h>
#include <hip/hip_cooperative_groups.h>
#include <cstdio>
namespace cg = cooperative_groups;

#ifndef MEGA
#define MEGA 0
#endif

typedef unsigned short bf16;
typedef __attribute__((ext_vector_type(8))) short bf16x8;
typedef __attribute__((ext_vector_type(16))) float f32x16;
typedef __attribute__((ext_vector_type(2))) float f32x2;
typedef __attribute__((ext_vector_type(2))) __bf16 bf2v;
#define DI __device__ __forceinline__
#define MFMA32(a, b, c) __builtin_amdgcn_mfma_f32_32x32x16_bf16((a), (b), (c), 0, 0, 0)

struct Params { const float* in[27]; float* out; char* ws; };

constexpr size_t OFF_CTR = 0;
constexpr size_t OFF_MODS = 256;
constexpr size_t OFF_LAM = OFF_MODS + 2ull * 3 * 6144 * 4;
constexpr size_t OFF_TAB32 = OFF_LAM + 256;
constexpr size_t OFF_TAB64 = OFF_TAB32 + 4096;
constexpr size_t OFF_WIN = OFF_TAB64 + 8192;
constexpr size_t OFF_WOUT = OFF_WIN + 2ull * 2176 * 1024 * 2;
constexpr size_t OFF_WUQ = OFF_WOUT + 2ull * 1024 * 1024 * 2;
constexpr size_t OFF_WUKV = OFF_WUQ + 2ull * 384 * 192 * 2;
constexpr size_t OFF_DFTL = OFF_WUKV + 2ull * 512 * 128 * 2;
constexpr size_t OFF_DFTC = OFF_DFTL + 4096ull * 8192 * 2;
constexpr size_t OFF_W1 = OFF_DFTC + 256ull * 512 * 2;
constexpr size_t OFF_W2 = OFF_W1 + 4096ull * 1024 * 2;
constexpr size_t OFF_HBUF = OFF_W2 + 4096ull * 1024 * 2;
constexpr size_t OFF_R = OFF_HBUF + 16384ull * 1024 * 2;
constexpr size_t OFF_A = OFF_R;
constexpr size_t OFF_Z = OFF_R;
constexpr size_t OFF_QROT = OFF_Z + 17408ull * 1280 * 2;
constexpr size_t OFF_QMP = OFF_QROT + 8192ull * 512 * 2;
constexpr size_t OFF_QMR = OFF_QMP + 16384ull * 384 * 2;
constexpr size_t OFF_KM = OFF_QMR + 8192ull * 384 * 2;
constexpr size_t OFF_VTMC = OFF_KM + 17408ull * 384 * 2;
constexpr size_t OFF_VTML = OFF_VTMC + 32ull * 4 * 64 * 256 * 2;
constexpr size_t OFF_VTDC = OFF_VTML + 2ull * 4 * 64 * 4608 * 2;
constexpr size_t OFF_VTDL = OFF_VTDC + 32ull * 4 * 64 * 256 * 2;
constexpr size_t OFF_VTGC = OFF_VTDL + 2ull * 4 * 64 * 4608 * 2;
constexpr size_t OFF_VTGL = OFF_VTGC + 32ull * 2 * 64 * 256 * 2;
constexpr size_t OFF_PQTC = OFF_VTGL + 2ull * 2 * 64 * 4608 * 2;
constexpr size_t OFF_PQTL = OFF_PQTC + 32ull * 256 * 512 * 2;
constexpr size_t OFF_KDC = OFF_PQTL + 2ull * 256 * 8192 * 2;
constexpr size_t OFF_KGC = OFF_KDC + 2ull * 512 * 256 * 2;
constexpr size_t OFF_END = OFF_KGC + 2ull * 512 * 128 * 2;

constexpr size_t O_DK = 16777216, O_DV = 20971520, O_CKV = 25165824, O_KR = 27262976, O_GK = 27787264, O_GV = 29884416;

constexpr int SMEM_BYTES = 73728 + 16;
constexpr int ZLD = 1280;

DI unsigned pack2(float a, float b) { f32x2 v = {a, b}; bf2v r = __builtin_convertvector(v, bf2v); return __builtin_bit_cast(unsigned, r); }
DI bf16 f2bf(float a) { return (bf16)(pack2(a, 0.f) & 0xffffu); }
DI float bf2f(bf16 b) { return __uint_as_float(((unsigned)b) << 16); }
DI float wsum(float v) { for (int o = 32; o > 0; o >>= 1) v += __shfl_xor(v, o, 64); return v; }
DI int whichmod(int t) { return t < 8192 ? 0 : 1 + ((t - 8192) >> 12); }
DI const float* xrow(const Params& p, int l, int t) {
  if (l == 0) return t < 8192 ? p.in[0] + (size_t)t * 1024 : p.in[1] + (size_t)(t - 8192) * 1024;
  return p.out + (size_t)t * 1024;
}
DI const float* modp(const Params& p, int l, int w, int i) { return (const float*)(p.ws + OFF_MODS) + ((size_t)(l * 3 + w) * 6 + i) * 1024; }
DI void st4bf(bf16* dst, float a, float b, float c, float d) { uint2 u; u.x = pack2(a, b); u.y = pack2(c, d); *(uint2*)dst = u; }

template <class Epi>
DI void gemm_tile(const bf16* __restrict__ A, int lda, const bf16* __restrict__ Bt, int ldb, int K, int m0, int n0, char* smem, Epi epi) {
  bf16* As = (bf16*)smem;
  bf16* Bs = As + 2 * 128 * 72;
  const int tid = threadIdx.x, lane = tid & 63, wave = tid >> 6;
  const int r = lane & 31, h = lane >> 5, wm = wave >> 1, wn = wave & 1;
  const int lr = tid >> 3, lc = (tid & 7) * 8;
  const bf16* ag = A + (size_t)(m0 + lr) * lda + lc;
  const bf16* bg = Bt + (size_t)(n0 + lr) * ldb + lc;
  f32x16 acc[2][2];
#pragma unroll
  for (int i = 0; i < 2; ++i)
#pragma unroll
    for (int j = 0; j < 2; ++j)
#pragma unroll
      for (int e = 0; e < 16; ++e) acc[i][j][e] = 0.f;
  uint4 ra[4], rb[4];
  __syncthreads();
#pragma unroll
  for (int i = 0; i < 4; ++i) { ra[i] = *(const uint4*)(ag + (size_t)(32 * i) * lda); rb[i] = *(const uint4*)(bg + (size_t)(32 * i) * ldb); }
#pragma unroll
  for (int i = 0; i < 4; ++i) { *(uint4*)(As + (lr + 32 * i) * 72 + lc) = ra[i]; *(uint4*)(Bs + (lr + 32 * i) * 72 + lc) = rb[i]; }
  __syncthreads();
  const int nk = K >> 6;
  for (int kt = 0; kt < nk; ++kt) {
    const int buf = kt & 1;
    if (kt + 1 < nk) {
      const int k0 = (kt + 1) << 6;
#pragma unroll
      for (int i = 0; i < 4; ++i) { ra[i] = *(const uint4*)(ag + (size_t)(32 * i) * lda + k0); rb[i] = *(const uint4*)(bg + (size_t)(32 * i) * ldb + k0); }
    }
    const bf16* as = As + (buf * 128 + wm * 64 + r) * 72 + 8 * h;
    const bf16* bs = Bs + (buf * 128 + wn * 64 + r) * 72 + 8 * h;
#pragma unroll
    for (int ks = 0; ks < 4; ++ks) {
      bf16x8 a0 = *(const bf16x8*)(as + ks * 16), a1 = *(const bf16x8*)(as + 32 * 72 + ks * 16);
      bf16x8 b0 = *(const bf16x8*)(bs + ks * 16), b1 = *(const bf16x8*)(bs + 32 * 72 + ks * 16);
      acc[0][0] = MFMA32(a0, b0, acc[0][0]);
      acc[0][1] = MFMA32(a0, b1, acc[0][1]);
      acc[1][0] = MFMA32(a1, b0, acc[1][0]);
      acc[1][1] = MFMA32(a1, b1, acc[1][1]);
    }
    if (kt + 1 < nk) {
      const int nb = buf ^ 1;
#pragma unroll
      for (int i = 0; i < 4; ++i) { *(uint4*)(As + (nb * 128 + lr + 32 * i) * 72 + lc) = ra[i]; *(uint4*)(Bs + (nb * 128 + lr + 32 * i) * 72 + lc) = rb[i]; }
    }
    __syncthreads();
  }
#pragma unroll
  for (int i = 0; i < 2; ++i)
#pragma unroll
    for (int j = 0; j < 2; ++j)
#pragma unroll
      for (int g = 0; g < 4; ++g) {
        const int m = m0 + wm * 64 + i * 32 + 8 * g + 4 * h;
        const int n = n0 + wn * 64 + j * 32 + r;
        epi(m, n, acc[i][j][4 * g], acc[i][j][4 * g + 1], acc[i][j][4 * g + 2], acc[i][j][4 * g + 3]);
      }
}

struct AttnArgs {
  const bf16 *Qa, *Qb, *Ka, *Kb, *Vt;
  int qsa, qsb, ksa, ksb, vs, nkeys, nsplit;
  float c;
};

template <int DQK>
DI void attn_core(const AttnArgs& a, char* smem, f32x16& o0, f32x16& o1) {
  constexpr int NS = DQK / 16;
  constexpr int KROW = DQK + 8;
  constexpr int KCH = DQK / 8;
  constexpr int NKL = (64 * KCH) / 256;
  bf16* Ks = (bf16*)smem;
  bf16* Vs = Ks + 2 * 64 * KROW;
  const int tid = threadIdx.x, lane = tid & 63, wave = tid >> 6;
  const int r = lane & 31, h = lane >> 5;
  const int pr = (r & ~12) | ((r & 4) << 1) | ((r & 8) >> 1);
  bf16x8 qf[NS];
  {
    const bf16* qp = a.Qa + (size_t)(wave * 32 + r) * a.qsa + 8 * h;
#pragma unroll
    for (int s = 0; s < NS; ++s) qf[s] = *(const bf16x8*)(qp + s * 16);
  }
#pragma unroll
  for (int e = 0; e < 16; ++e) { o0[e] = 0.f; o1[e] = 0.f; }
  float mrun = -1e30f, lrun = 0.f;
  uint4 rk[NKL], rv[2];
  const int nt = a.nkeys >> 6;
  auto gload = [&](int kt) {
    const int key0 = kt << 6;
    const bf16* kb; int ks;
    if (key0 < a.nsplit) { kb = a.Ka + (size_t)key0 * a.ksa; ks = a.ksa; } else { kb = a.Kb + (size_t)(key0 - a.nsplit) * a.ksb; ks = a.ksb; }
#pragma unroll
    for (int i = 0; i < NKL; ++i) { const int ci = tid + 256 * i; const int row = ci / KCH, ch = ci % KCH; rk[i] = *(const uint4*)(kb + (size_t)row * ks + ch * 8); }
#pragma unroll
    for (int i = 0; i < 2; ++i) { const int ci = tid + 256 * i; const int row = ci >> 3, ch = ci & 7; rv[i] = *(const uint4*)(a.Vt + (size_t)row * a.vs + key0 + ch * 8); }
  };
  auto sstore = [&](int buf) {
#pragma unroll
    for (int i = 0; i < NKL; ++i) { const int ci = tid + 256 * i; const int row = ci / KCH, ch = ci % KCH; *(uint4*)(Ks + (buf * 64 + row) * KROW + ch * 8) = rk[i]; }
#pragma unroll
    for (int i = 0; i < 2; ++i) { const int ci = tid + 256 * i; const int row = ci >> 3, ch = ci & 7; *(uint4*)(Vs + (buf * 64 + row) * 72 + ch * 8) = rv[i]; }
  };
  __syncthreads();
  gload(0); sstore(0);
  __syncthreads();
  for (int kt = 0; kt < nt; ++kt) {
    const int buf = kt & 1;
    if (kt + 1 < nt) gload(kt + 1);
    if ((kt << 6) == a.nsplit) {
      const bf16* qp = a.Qb + (size_t)(wave * 32 + r) * a.qsb + 8 * h;
#pragma unroll
      for (int s = 0; s < NS; ++s) qf[s] = *(const bf16x8*)(qp + s * 16);
    }
    f32x16 s0, s1;
#pragma unroll
    for (int e = 0; e < 16; ++e) { s0[e] = 0.f; s1[e] = 0.f; }
    const bf16* kp = Ks + (buf * 64 + pr) * KROW + 8 * h;
#pragma unroll
    for (int s = 0; s < NS; ++s) {
      bf16x8 k0 = *(const bf16x8*)(kp + s * 16), k1 = *(const bf16x8*)(kp + 32 * KROW + s * 16);
      s0 = MFMA32(k0, qf[s], s0);
      s1 = MFMA32(k1, qf[s], s1);
    }
    float mx = s0[0];
#pragma unroll
    for (int e = 1; e < 16; ++e) mx = fmaxf(mx, s0[e]);
#pragma unroll
    for (int e = 0; e < 16; ++e) mx = fmaxf(mx, s1[e]);
    mx = fmaxf(mx, __shfl_xor(mx, 32, 64));
    const float mnew = fmaxf(mrun, mx * a.c);
    const float alpha = __builtin_amdgcn_exp2f(mrun - mnew);
    mrun = mnew;
    float psum = 0.f;
#pragma unroll
    for (int e = 0; e < 16; ++e) { s0[e] = __builtin_amdgcn_exp2f(s0[e] * a.c - mnew); psum += s0[e]; }
#pragma unroll
    for (int e = 0; e < 16; ++e) { s1[e] = __builtin_amdgcn_exp2f(s1[e] * a.c - mnew); psum += s1[e]; }
    lrun = lrun * alpha + psum;
#pragma unroll
    for (int e = 0; e < 16; ++e) { o0[e] *= alpha; o1[e] *= alpha; }
    const bf16* vp = Vs + (buf * 64 + r) * 72 + 8 * h;
#pragma unroll
    for (int s = 0; s < 2; ++s) {
      uint4 u;
      u.x = pack2(s0[8 * s], s0[8 * s + 1]); u.y = pack2(s0[8 * s + 2], s0[8 * s + 3]);
      u.z = pack2(s0[8 * s + 4], s0[8 * s + 5]); u.w = pack2(s0[8 * s + 6], s0[8 * s + 7]);
      bf16x8 pf = __builtin_bit_cast(bf16x8, u);
      bf16x8 v0 = *(const bf16x8*)(vp + 16 * s), v1 = *(const bf16x8*)(vp + 32 * 72 + 16 * s);
      o0 = MFMA32(v0, pf, o0);
      o1 = MFMA32(v1, pf, o1);
    }
#pragma unroll
    for (int s = 0; s < 2; ++s) {
      uint4 u;
      u.x = pack2(s1[8 * s], s1[8 * s + 1]); u.y = pack2(s1[8 * s + 2], s1[8 * s + 3]);
      u.z = pack2(s1[8 * s + 4], s1[8 * s + 5]); u.w = pack2(s1[8 * s + 6], s1[8 * s + 7]);
      bf16x8 pf = __builtin_bit_cast(bf16x8, u);
      bf16x8 v0 = *(const bf16x8*)(vp + 32 + 16 * s), v1 = *(const bf16x8*)(vp + 32 * 72 + 32 + 16 * s);
      o0 = MFMA32(v0, pf, o0);
      o1 = MFMA32(v1, pf, o1);
    }
    if (kt + 1 < nt) sstore(buf ^ 1);
    __syncthreads();
  }
  const float ltot = lrun + __shfl_xor(lrun, 32, 64);
  const float inv = 1.f / ltot;
#pragma unroll
  for (int e = 0; e < 16; ++e) { o0[e] *= inv; o1[e] *= inv; }
}

DI void write_o(bf16* dst, const f32x16& o0, const f32x16& o1, int h) {
#pragma unroll
  for (int g = 0; g < 4; ++g) {
    st4bf(dst + 8 * g + 4 * h, o0[4 * g], o0[4 * g + 1], o0[4 * g + 2], o0[4 * g + 3]);
    st4bf(dst + 32 + 8 * g + 4 * h, o1[4 * g], o1[4 * g + 1], o1[4 * g + 2], o1[4 * g + 3]);
  }
}

DI void convT_units(const float* __restrict__ src, int ldsrc, int srccol0, bf16* __restrict__ dst, int K, int N, int dstrow0, int unit) {
  const int n = unit % N, kc = unit / N;
  const float* s = src + (size_t)(kc * 8) * ldsrc + srccol0 + n;
  float v[8];
#pragma unroll
  for (int j = 0; j < 8; ++j) v[j] = s[(size_t)j * ldsrc];
  uint4 u; u.x = pack2(v[0], v[1]); u.y = pack2(v[2], v[3]); u.z = pack2(v[4], v[5]); u.w = pack2(v[6], v[7]);
  *(uint4*)(dst + (size_t)(dstrow0 + n) * K + kc * 8) = u;
}

DI int seg_src(int n) {
  if (n < 512) return n;
  if (n < 704) return 1024 + (n - 512);
  if (n < 832) return 1216 + (n - 704);
  if (n < 864) return 1344 + (n - 832);
  if (n < 1120) return 1376 + (n - 864);
  if (n < 1248) return 1632 + (n - 1120);
  if (n < 1280) return -1;
  if (n < 1536) return 512 + (n - 1280);
  return 1760 + (n - 1536);
}

DI void phase0(const Params& p, char* smem) {
  const int tid = threadIdx.x;
  float* tab = (float*)smem;
  float* sil = tab + 4096;
  float* red = sil + 3072;
  for (int i = tid; i < 4096; i += 256) tab[i] = cospif((float)i * (1.0f / 2048.0f));
  for (int i = tid; i < 1024; i += 256) {
    float a = p.in[9][i], b = p.in[8][i], c = p.in[8][1024 + i];
    sil[i] = a / (1.f + __expf(-a)); sil[1024 + i] = b / (1.f + __expf(-b)); sil[2048 + i] = c / (1.f + __expf(-c));
  }
  __syncthreads();
  float* mods = (float*)(p.ws + OFF_MODS);
  constexpr int N_MODS = 192, N_MISC = 1;
  constexpr int U_WIN = 1664 * 128;
  constexpr int U_WPQ = 512 * 128;
  constexpr int U_WOUT = 1024 * 128, U_WUQ = 384 * 24, U_WUKV = 512 * 16;
  constexpr int I_WIN = 2 * U_WIN / 256, I_WPQ = 2 * U_WPQ / 256, I_WOUT = 2 * U_WOUT / 256, I_WUQ = 2 * U_WUQ / 256, I_WUKV = 2 * U_WUKV / 256;
  constexpr int I_DFTL = 4096 * 1024 / 256, I_DFTC = 256 * 64 / 256;
  constexpr int B0 = N_MODS, B1 = B0 + N_MISC, B2 = B1 + I_WIN, B3 = B2 + I_WPQ, B4 = B3 + I_WOUT, B5 = B4 + I_WUQ, B6 = B5 + I_WUKV, B7 = B6 + I_DFTL, B8 = B7 + I_DFTC;
  for (int it = blockIdx.x; it < B8; it += gridDim.x) {
    if (it < B0) {
      const int l = it / 96, cg = it % 96, j = tid & 63, kq = tid >> 6;
      const float* w = p.in[12] + ((size_t)l * 1024 + kq * 256) * 6144 + cg * 64 + j;
      float a0 = 0.f, a1 = 0.f, a2 = 0.f;
#pragma unroll 8
      for (int k = 0; k < 256; ++k) { const float wv = w[(size_t)k * 6144]; const int kk = kq * 256 + k; a0 += sil[kk] * wv; a1 += sil[1024 + kk] * wv; a2 += sil[2048 + kk] * wv; }
      red[(kq * 3 + 0) * 64 + j] = a0; red[(kq * 3 + 1) * 64 + j] = a1; red[(kq * 3 + 2) * 64 + j] = a2;
      __syncthreads();
      if (tid < 192) {
        const int w3 = tid >> 6, jj = tid & 63, col = cg * 64 + jj;
        float s = red[(0 * 3 + w3) * 64 + jj] + red[(1 * 3 + w3) * 64 + jj] + red[(2 * 3 + w3) * 64 + jj] + red[(3 * 3 + w3) * 64 + jj];
        mods[(size_t)(l * 3 + w3) * 6144 + col] = s + p.in[13][l * 6144 + col];
      }
      __syncthreads();
    } else if (it < B1) {
      float* lam = (float*)(p.ws + OFF_LAM);
      if (tid < 2) {
        const float* lp = p.in[15] + tid * 128;
        float d1 = 0.f, d2 = 0.f;
        for (int i = 0; i < 32; ++i) { d1 += lp[i] * lp[32 + i]; d2 += lp[64 + i] * lp[96 + i]; }
        const float li = 0.8f - 0.6f * expf(-0.3f * (float)tid);
        lam[tid * 2] = expf(d1) - expf(d2) + li;
        lam[tid * 2 + 1] = li;
      }
      float* t32 = (float*)(p.ws + OFF_TAB32);
      float* t64 = (float*)(p.ws + OFF_TAB64);
      for (int i = tid; i < 512; i += 256) {
        const int pos = i >> 3, pp = i & 7;
        const float inv = exp2f(-(float)pp * (13.287712379549449f / 8.f));
        const float ap = (float)pos * inv * 0.3183098861837907f;
        t32[i * 2] = cospif(ap); t32[i * 2 + 1] = sinpif(ap);
      }
      for (int i = tid; i < 1024; i += 256) {
        const int pos = i >> 4, pp = i & 15;
        const float inv = exp2f(-(float)pp * (13.287712379549449f / 16.f));
        const float ap = (float)pos * inv * 0.3183098861837907f;
        t64[i * 2] = cospif(ap); t64[i * 2 + 1] = sinpif(ap);
      }
    } else if (it < B2) {
      int u = (it - B1) * 256 + tid;
      const int l = u / U_WIN; u -= l * U_WIN;
      const int n = u % 1664, kc = u / 1664;
      bf16* dst = (bf16*)(p.ws + OFF_WIN) + (size_t)l * 2176 * 1024;
      const int sc = seg_src(n);
      uint4 uu = {0u, 0u, 0u, 0u};
      if (sc >= 0) {
        const float* s = p.in[14] + (size_t)l * 1024 * 1888 + (size_t)(kc * 8) * 1888 + sc;
        float v[8];
#pragma unroll
        for (int j = 0; j < 8; ++j) v[j] = s[(size_t)j * 1888];
        uu.x = pack2(v[0], v[1]); uu.y = pack2(v[2], v[3]); uu.z = pack2(v[4], v[5]); uu.w = pack2(v[6], v[7]);
      }
      *(uint4*)(dst + (size_t)n * 1024 + kc * 8) = uu;
    } else if (it < B3) {
      int u = (it - B2) * 256 + tid;
      const int l = u / U_WPQ; u -= l * U_WPQ;
      const int nn = u % 512, kc = u / 512;
      const int isq = nn >> 8, g = (nn >> 6) & 3, m = nn & 63;
      const float* s = p.in[14] + (size_t)l * 1024 * 1888 + (size_t)(kc * 8) * 1888 + 768 + g * 64;
      float v[8] = {0.f, 0.f, 0.f, 0.f, 0.f, 0.f, 0.f, 0.f};
      for (int c = 0; c < 64; ++c) {
        const int idx = ((m * c) & 63) * 64 + (isq ? 3072 : 0);
        const float tw = tab[idx & 4095];
#pragma unroll
        for (int j = 0; j < 8; ++j) v[j] += s[(size_t)j * 1888 + c] * tw;
      }
      uint4 uu; uu.x = pack2(v[0], v[1]); uu.y = pack2(v[2], v[3]); uu.z = pack2(v[4], v[5]); uu.w = pack2(v[6], v[7]);
      bf16* dst = (bf16*)(p.ws + OFF_WIN) + (size_t)l * 2176 * 1024;
      *(uint4*)(dst + (size_t)(1664 + nn) * 1024 + kc * 8) = uu;
    } else if (it < B4) {
      int u = (it - B3) * 256 + tid; const int l = u / U_WOUT; u -= l * U_WOUT;
      convT_units(p.in[23] + (size_t)l * 1024 * 1024, 1024, 0, (bf16*)(p.ws + OFF_WOUT) + (size_t)l * 1024 * 1024, 1024, 1024, 0, u);
    } else if (it < B5) {
      int u = (it - B4) * 256 + tid; const int l = u / U_WUQ; u -= l * U_WUQ;
      convT_units(p.in[18] + (size_t)l * 192 * 384, 384, 0, (bf16*)(p.ws + OFF_WUQ) + (size_t)l * 384 * 192, 192, 384, 0, u);
    } else if (it < B6) {
      int u = (it - B5) * 256 + tid; const int l = u / U_WUKV; u -= l * U_WUKV;
      convT_units(p.in[20] + (size_t)l * 128 * 512, 512, 0, (bf16*)(p.ws + OFF_WUKV) + (size_t)l * 512 * 128, 128, 512, 0, u);
    } else if (it < B7) {
      const int u = (it - B6) * 256 + tid;
      const int k = u >> 10, c0 = (u & 1023) * 8;
      float v[8];
#pragma unroll
      for (int j = 0; j < 8; ++j) { const int col = c0 + j; const int s = col & 4095; const int idx = (k * s + (col >= 4096 ? 1024 : 0)) & 4095; v[j] = tab[idx] * (1.f / 512.f); }
      uint4 uu; uu.x = pack2(v[0], v[1]); uu.y = pack2(v[2], v[3]); uu.z = pack2(v[4], v[5]); uu.w = pack2(v[6], v[7]);
      *(uint4*)((bf16*)(p.ws + OFF_DFTL) + (size_t)k * 8192 + c0) = uu;
    } else {
      const int u = (it - B7) * 256 + tid;
      const int k = u >> 6, c0 = (u & 63) * 8;
      float v[8];
#pragma unroll
      for (int j = 0; j < 8; ++j) { const int col = c0 + j; const int s = col & 255; const int idx = (16 * ((k * s) & 255) + (col >= 256 ? 1024 : 0)) & 4095; v[j] = tab[idx] * (1.f / 128.f); }
      uint4 uu; uu.x = pack2(v[0], v[1]); uu.y = pack2(v[2], v[3]); uu.z = pack2(v[4], v[5]); uu.w = pack2(v[6], v[7]);
      *(uint4*)((bf16*)(p.ws + OFF_DFTC) + (size_t)k * 512 + c0) = uu;
    }
  }
}

DI void modnorm_rows(const Params& p, int l, int item, const float* gvec, int ish, int isc) {
  const int lane = threadIdx.x & 63, wave = threadIdx.x >> 6;
  const int t = item * 4 + wave;
  const float* x = xrow(p, (ish == 0) ? l : 1, t);
  float4 v[4];
  float ss = 0.f;
#pragma unroll
  for (int i = 0; i < 4; ++i) { v[i] = *(const float4*)(x + lane * 4 + 256 * i); ss += v[i].x * v[i].x + v[i].y * v[i].y + v[i].z * v[i].z + v[i].w * v[i].w; }
  ss = wsum(ss);
  const float rstd = rsqrtf(ss * (1.f / 1024.f) + 1e-6f);
  const int w = whichmod(t);
  const float* sh = modp(p, l, w, ish);
  const float* sc = modp(p, l, w, isc);
  bf16* hb = (bf16*)(p.ws + OFF_HBUF) + (size_t)t * 1024;
#pragma unroll
  for (int i = 0; i < 4; ++i) {
    const int n = lane * 4 + 256 * i;
    const float4 g = *(const float4*)(gvec + n), s1 = *(const float4*)(sc + n), s0 = *(const float4*)(sh + n);
    st4bf(hb + n, v[i].x * rstd * g.x * (1.f + s1.x) + s0.x, v[i].y * rstd * g.y * (1.f + s1.y) + s0.y,
          v[i].z * rstd * g.z * (1.f + s1.z) + s0.z, v[i].w * rstd * g.w * (1.f + s1.w) + s0.w);
  }
}

DI void phaseA(const Params& p, int l) {
  const int tid = threadIdx.x;
  constexpr int I_ROWS = 4096;
  constexpr int U_W1 = 4096 * 128, U_W2 = 1024 * 512;
  constexpr int I_W1 = U_W1 / 256, I_W2 = U_W2 / 256;
  constexpr int I_KDC = 128, I_KGC = 64, I_VTD = 128, I_VTG = 64, I_CKV = 64, I_KR = 128;
  constexpr int B0 = I_ROWS, B1 = B0 + I_W1, B2 = B1 + I_W2, B3 = B2 + I_KDC, B4 = B3 + I_KGC, B5 = B4 + I_VTD, B6 = B5 + I_VTG, B7 = B6 + I_CKV, B8 = B7 + I_KR;
  for (int it = blockIdx.x; it < B8; it += gridDim.x) {
    if (it < B0) {
      modnorm_rows(p, l, it, p.in[10] + l * 1024, 0, 1);
    } else if (it < B1) {
      convT_units(p.in[24] + (size_t)l * 1024 * 4096, 4096, 0, (bf16*)(p.ws + OFF_W1), 1024, 4096, 0, (it - B0) * 256 + tid);
    } else if (it < B2) {
      convT_units(p.in[25] + (size_t)l * 4096 * 1024, 1024, 0, (bf16*)(p.ws + OFF_W2), 4096, 1024, 0, (it - B1) * 256 + tid);
    } else if (it < B3) {
      const int u = (it - B2) * 256 + tid;
      const int e0 = u * 8, b = e0 >> 17, rem = e0 & 131071;
      const float* s = p.in[2] + ((size_t)(b * 2 + l) * 512) * 256 + rem;
      const float4 x0 = *(const float4*)s, x1 = *(const float4*)(s + 4);
      uint4 uu; uu.x = pack2(x0.x, x0.y); uu.y = pack2(x0.z, x0.w); uu.z = pack2(x1.x, x1.y); uu.w = pack2(x1.z, x1.w);
      *(uint4*)((bf16*)(p.ws + OFF_KDC) + e0) = uu;
    } else if (it < B4) {
      const int u = (it - B3) * 256 + tid;
      const int e0 = u * 8, b = e0 >> 16, rem = e0 & 65535;
      const float* s = p.in[6] + ((size_t)(b * 2 + l) * 512) * 128 + rem;
      const float4 x0 = *(const float4*)s, x1 = *(const float4*)(s + 4);
      uint4 uu; uu.x = pack2(x0.x, x0.y); uu.y = pack2(x0.z, x0.w); uu.z = pack2(x1.x, x1.y); uu.w = pack2(x1.z, x1.w);
      *(uint4*)((bf16*)(p.ws + OFF_KGC) + e0) = uu;
    } else if (it < B5) {
      const int u = (it - B4) * 256 + tid;
      const int c = u & 255, jc = (u >> 8) & 63, b = u >> 14;
      const float* s = p.in[3] + ((size_t)(b * 2 + l) * 512 + jc * 8) * 256 + c;
      float v[8];
#pragma unroll
      for (int j = 0; j < 8; ++j) v[j] = s[j * 256];
      uint4 uu; uu.x = pack2(v[0], v[1]); uu.y = pack2(v[2], v[3]); uu.z = pack2(v[4], v[5]); uu.w = pack2(v[6], v[7]);
      *(uint4*)((bf16*)(p.ws + OFF_VTDL) + ((size_t)(b * 256 + c)) * 4608 + 4096 + jc * 8) = uu;
    } else if (it < B6) {
      const int u = (it - B5) * 256 + tid;
      const int c = u & 127, jc = (u >> 7) & 63, b = u >> 13;
      const float* s = p.in[7] + ((size_t)(b * 2 + l) * 512 + jc * 8) * 128 + c;
      float v[8];
#pragma unroll
      for (int j = 0; j < 8; ++j) v[j] = s[j * 128];
      uint4 uu; uu.x = pack2(v[0], v[1]); uu.y = pack2(v[2], v[3]); uu.z = pack2(v[4], v[5]); uu.w = pack2(v[6], v[7]);
      *(uint4*)((bf16*)(p.ws + OFF_VTGL) + ((size_t)(b * 128 + c)) * 4608 + 4096 + jc * 8) = uu;
    } else if (it < B7) {
      const int u = (it - B6) * 256 + tid;
      const int e0 = u * 8, b = e0 >> 16, rem = e0 & 65535, j = rem >> 7, e = rem & 127;
      const float* s = p.in[4] + ((size_t)(b * 2 + l) * 512) * 128 + rem;
      const float4 x0 = *(const float4*)s, x1 = *(const float4*)(s + 4);
      uint4 uu; uu.x = pack2(x0.x, x0.y); uu.y = pack2(x0.z, x0.w); uu.z = pack2(x1.x, x1.y); uu.w = pack2(x1.z, x1.w);
      *(uint4*)((bf16*)(p.ws + OFF_Z) + (size_t)(16384 + b * 512 + j) * ZLD + 704 + e) = uu;
    } else {
      const int u = (it - B7) * 256 + tid;
      const int e = u & 31, j = (u >> 5) & 511, b = u >> 14;
      const bf16 v = f2bf(p.in[5][((size_t)(b * 2 + l) * 512 + j) * 32 + e]);
      bf16* km = (bf16*)(p.ws + OFF_KM) + (size_t)(16384 + b * 512 + j) * 384 + 64 + e;
      km[0] = v; km[96] = v; km[192] = v; km[288] = v;
    }
  }
}

DI void phaseB(const Params& p, int l, char* smem) {
  const bf16* A = (const bf16*)(p.ws + OFF_HBUF);
  const bf16* Bt = (const bf16*)(p.ws + OFF_WIN) + (size_t)l * 2176 * 1024;
  bf16* Z = (bf16*)(p.ws + OFF_Z);
  bf16* vtdc = (bf16*)(p.ws + OFF_VTDC); bf16* vtdl = (bf16*)(p.ws + OFF_VTDL);
  bf16* vtgc = (bf16*)(p.ws + OFF_VTGC); bf16* vtgl = (bf16*)(p.ws + OFF_VTGL);
  bf16* pqc = (bf16*)(p.ws + OFF_PQTC); bf16* pql = (bf16*)(p.ws + OFF_PQTL);
  float* out = p.out;
  for (int it = blockIdx.x; it < 128 * 17; it += gridDim.x) {
    const int mt = it / 17, nt = it % 17;
    gemm_tile(A, 1024, Bt, 1024, 1024, mt * 128, nt * 128, smem, [&](int m, int n, float v0, float v1, float v2, float v3) {
      if (n < 1280) {
        bf16* z = Z + (size_t)m * ZLD + n;
        z[0] = f2bf(v0); z[ZLD] = f2bf(v1); z[2 * ZLD] = f2bf(v2); z[3 * ZLD] = f2bf(v3);
      } else {
        const bool ctx = m < 8192;
        const int b = ctx ? (m >> 8) : ((m - 8192) >> 12);
        const int s = ctx ? (m & 255) : ((m - 8192) & 4095);
        if (n < 1536) {
          const int c = n - 1280;
          if (ctx) {
            st4bf(vtdc + ((size_t)(b * 256 + c)) * 256 + s, v0, v1, v2, v3);
            float* o = out + O_DV + ((size_t)(b * 2 + l) * 256 + s) * 256 + c;
            o[0] = v0; o[256] = v1; o[512] = v2; o[768] = v3;
          } else st4bf(vtdl + ((size_t)(b * 256 + c)) * 4608 + s, v0, v1, v2, v3);
        } else if (n < 1664) {
          const int c = n - 1536;
          if (ctx) {
            st4bf(vtgc + ((size_t)(b * 128 + c)) * 256 + s, v0, v1, v2, v3);
            float* o = out + O_GV + ((size_t)(b * 2 + l) * 256 + s) * 128 + c;
            o[0] = v0; o[128] = v1; o[256] = v2; o[384] = v3;
          } else st4bf(vtgl + ((size_t)(b * 128 + c)) * 4608 + s, v0, v1, v2, v3);
        } else {
          const int c = n - 1664, isq = c >> 8, ch = c & 255;
          if (ctx) st4bf(pqc + ((size_t)(b * 256 + ch)) * 512 + isq * 256 + s, v0, v1, v2, v3);
          else st4bf(pql + ((size_t)(b * 256 + ch)) * 8192 + isq * 4096 + s, v0, v1, v2, v3);
        }
      }
    });
  }
}

DI float rope_elem(const float* x, int i, int a  , const float* tab, int prow, int pcol) {
  const int half = i / a, idx = i % a, hp = a >> 1, pp = idx % hp, second = idx / hp;
  const int pos = half ? pcol : prow;
  const float c = tab[(pos * hp + pp) * 2], s = tab[(pos * hp + pp) * 2 + 1];
  const float x1 = x[half * a + pp], x2 = x[half * a + hp + pp];
  return second ? (x1 * s + x2 * c) : (x1 * c - x2 * s);
}

DI void phaseC(const Params& p, int l, char* smem) {
  const int tid = threadIdx.x, lane = tid & 63, wave = tid >> 6;
  float* xs = (float*)smem + wave * 1280;
  bf16* Z = (bf16*)(p.ws + OFF_Z);
  bf16* QR = (bf16*)(p.ws + OFF_QROT);
  bf16* KM = (bf16*)(p.ws + OFF_KM);
  const float* t32 = (const float*)(p.ws + OFF_TAB32);
  const float* t64 = (const float*)(p.ws + OFF_TAB64);
  const float* gq = p.in[17] + l * 192;
  const float* gkv = p.in[19] + l * 128;
  const float* ggq = p.in[21] + l * 64;
  const float* ggk = p.in[22] + l * 64;
  float* out = p.out;
  for (int it = blockIdx.x; it < 4096; it += gridDim.x) {
    const int t = it * 4 + wave;
    const bool ctx = t < 8192;
    const int b = ctx ? (t >> 8) : ((t - 8192) >> 12);
    const int s = ctx ? (t & 255) : ((t - 8192) & 4095);
    const int tl = t - 8192;
    const int prow = s >> 6, pcol = s & 63;
    bf16* z = Z + (size_t)t * ZLD;
    __syncthreads();
    for (int ci = lane; ci < 156; ci += 64) {
      const uint4 u = *(const uint4*)(z + ci * 8);
      float* d = xs + ci * 8;
      d[0] = __uint_as_float(u.x << 16); d[1] = __uint_as_float(u.x & 0xffff0000u);
      d[2] = __uint_as_float(u.y << 16); d[3] = __uint_as_float(u.y & 0xffff0000u);
      d[4] = __uint_as_float(u.z << 16); d[5] = __uint_as_float(u.z & 0xffff0000u);
      d[6] = __uint_as_float(u.w << 16); d[7] = __uint_as_float(u.w & 0xffff0000u);
    }
    __syncthreads();
    const size_t srow = (size_t)(b * 2 + l) * 256 + s;
#pragma unroll
    for (int j = 0; j < 4; ++j) {
      const int e = lane + 64 * j, m = e >> 5, i = e & 31;
      if (ctx) {
        out[O_DK + srow * 256 + e] = xs[256 + e];
      } else {
        QR[(size_t)tl * 512 + e] = f2bf(rope_elem(xs + m * 32, i, 16, t32, prow, pcol));
        z[256 + e] = f2bf(rope_elem(xs + 256 + m * 32, i, 16, t32, prow, pcol));
      }
    }
    {
      float v0 = xs[512 + lane], v1 = xs[576 + lane], v2 = xs[640 + lane];
      const float ss = wsum(v0 * v0 + v1 * v1 + v2 * v2);
      const float rstd = rsqrtf(ss * (1.f / 192.f) + 1e-6f);
      z[512 + lane] = f2bf(v0 * rstd * gq[lane]); z[576 + lane] = f2bf(v1 * rstd * gq[64 + lane]); z[640 + lane] = f2bf(v2 * rstd * gq[128 + lane]);
    }
    {
      float v0 = xs[704 + lane], v1 = xs[768 + lane];
      const float ss = wsum(v0 * v0 + v1 * v1);
      const float rstd = rsqrtf(ss * (1.f / 128.f) + 1e-6f);
      v0 = v0 * rstd * gkv[lane]; v1 = v1 * rstd * gkv[64 + lane];
      z[704 + lane] = f2bf(v0); z[768 + lane] = f2bf(v1);
      if (ctx) { out[O_CKV + srow * 128 + lane] = v0; out[O_CKV + srow * 128 + 64 + lane] = v1; }
    }
    {
      const int e = lane & 31, hh = (lane >> 5) * 2;
      float v;
      if (ctx) { v = xs[832 + e]; if (lane < 32) out[O_KR + srow * 32 + e] = v; }
      else v = rope_elem(xs + 832, e, 16, t32, prow, pcol);
      const bf16 bv = f2bf(v);
      KM[(size_t)t * 384 + hh * 96 + 64 + e] = bv;
      KM[(size_t)t * 384 + (hh + 1) * 96 + 64 + e] = bv;
    }
    float nq[4], nk[2];
#pragma unroll
    for (int hh = 0; hh < 4; ++hh) {
      const float v = xs[864 + hh * 64 + lane];
      const float ss = wsum(v * v);
      nq[hh] = v * rsqrtf(ss * (1.f / 64.f) + 1e-6f) * ggq[lane];
    }
#pragma unroll
    for (int hh = 0; hh < 2; ++hh) {
      const float v = xs[1120 + hh * 64 + lane];
      const float ss = wsum(v * v);
      nk[hh] = v * rsqrtf(ss * (1.f / 64.f) + 1e-6f) * ggk[lane];
    }
    __syncthreads();
#pragma unroll
    for (int hh = 0; hh < 4; ++hh) xs[864 + hh * 64 + lane] = nq[hh];
#pragma unroll
    for (int hh = 0; hh < 2; ++hh) xs[1120 + hh * 64 + lane] = nk[hh];
    __syncthreads();
#pragma unroll
    for (int hh = 0; hh < 4; ++hh) {
      z[864 + hh * 64 + lane] = f2bf(nq[hh]);
      if (!ctx) QR[(size_t)tl * 512 + 256 + hh * 64 + lane] = f2bf(rope_elem(xs + 864 + hh * 64, lane, 32, t64, prow, pcol));
    }
#pragma unroll
    for (int hh = 0; hh < 2; ++hh) {
      if (ctx) { z[1120 + hh * 64 + lane] = f2bf(nk[hh]); out[O_GK + srow * 128 + hh * 64 + lane] = nk[hh]; }
      else z[1120 + hh * 64 + lane] = f2bf(rope_elem(xs + 1120 + hh * 64, lane, 32, t64, prow, pcol));
    }
  }
}

DI void phaseD(const Params& p, int l, char* smem) {
  const bf16* Z = (const bf16*)(p.ws + OFF_Z);
  const bf16* Wuq = (const bf16*)(p.ws + OFF_WUQ) + (size_t)l * 384 * 192;
  const bf16* Wukv = (const bf16*)(p.ws + OFF_WUKV) + (size_t)l * 512 * 128;
  bf16* QMP = (bf16*)(p.ws + OFF_QMP); bf16* QMR = (bf16*)(p.ws + OFF_QMR);
  bf16* KM = (bf16*)(p.ws + OFF_KM);
  bf16* vtmc = (bf16*)(p.ws + OFF_VTMC); bf16* vtml = (bf16*)(p.ws + OFF_VTML);
  const float* t32 = (const float*)(p.ws + OFF_TAB32);
  constexpr int N1 = 128 * 3, N2 = 136 * 4;
  for (int it = blockIdx.x; it < N1 + N2; it += gridDim.x) {
    if (it < N1) {
      const int mt = it / 3, nt = it % 3;
      gemm_tile(Z + 512, ZLD, Wuq, 192, 192, mt * 128, nt * 128, smem, [&](int m, int n, float v0, float v1, float v2, float v3) {
        bf16* q = QMP + (size_t)m * 384 + n;
        q[0] = f2bf(v0); q[384] = f2bf(v1); q[768] = f2bf(v2); q[1152] = f2bf(v3);
        const float p0 = __shfl_xor(v0, 8, 64), p1 = __shfl_xor(v1, 8, 64), p2 = __shfl_xor(v2, 8, 64), p3 = __shfl_xor(v3, 8, 64);
        if (m >= 8192) {
          const int w = n % 96;
          float r0 = v0, r1 = v1, r2 = v2, r3 = v3;
          if (w >= 64) {
            const int i = w - 64, half = i >> 4, pp = i & 7, second = (i >> 3) & 1;
            float vv[4] = {v0, v1, v2, v3}, pv[4] = {p0, p1, p2, p3}, rr[4];
#pragma unroll
            for (int ii = 0; ii < 4; ++ii) {
              const int s = (m + ii - 8192) & 4095;
              const int pos = half ? (s & 63) : (s >> 6);
              const float c = t32[(pos * 8 + pp) * 2], sn = t32[(pos * 8 + pp) * 2 + 1];
              rr[ii] = second ? (pv[ii] * sn + vv[ii] * c) : (vv[ii] * c - pv[ii] * sn);
            }
            r0 = rr[0]; r1 = rr[1]; r2 = rr[2]; r3 = rr[3];
          }
          bf16* qr = QMR + (size_t)(m - 8192) * 384 + n;
          qr[0] = f2bf(r0); qr[384] = f2bf(r1); qr[768] = f2bf(r2); qr[1152] = f2bf(r3);
        }
      });
    } else {
      const int i2 = it - N1, mt = i2 >> 2, nt = i2 & 3;
      gemm_tile(Z + 704, ZLD, Wukv, 128, 128, mt * 128, nt * 128, smem, [&](int m, int n, float v0, float v1, float v2, float v3) {
        const int hd = n >> 7, w = n & 127;
        if (w < 64) {
          bf16* k = KM + (size_t)m * 384 + hd * 96 + w;
          k[0] = f2bf(v0); k[384] = f2bf(v1); k[768] = f2bf(v2); k[1152] = f2bf(v3);
        } else {
          const int dv = w - 64;
          if (m < 8192) {
            const int b = m >> 8, key = m & 255;
            st4bf(vtmc + ((size_t)((b * 4 + hd) * 64 + dv)) * 256 + key, v0, v1, v2, v3);
          } else {
            int b, key;
            if (m < 16384) { b = (m - 8192) >> 12; key = (m - 8192) & 4095; } else { b = (m - 16384) >> 9; key = 4096 + ((m - 16384) & 511); }
            st4bf(vtml + ((size_t)((b * 4 + hd) * 64 + dv)) * 4608 + key, v0, v1, v2, v3);
          }
        }
      });
    }
  }
}

DI void phaseE(const Params& p, int l, char* smem) {
  const int tid = threadIdx.x, lane = tid & 63, wave = tid >> 6, r = lane & 31, h = lane >> 5;
  int* ctr = (int*)(p.ws + OFF_CTR) + l;
  int* sitem = (int*)(smem + SMEM_BYTES - 16);
  bf16* Z = (bf16*)(p.ws + OFF_Z);
  bf16* QR = (bf16*)(p.ws + OFF_QROT);
  bf16* QMP = (bf16*)(p.ws + OFF_QMP); bf16* QMR = (bf16*)(p.ws + OFF_QMR);
  bf16* KM = (bf16*)(p.ws + OFF_KM);
  bf16* ymix = (bf16*)(p.ws + OFF_HBUF);
  const float lam = ((const float*)(p.ws + OFF_LAM))[l * 2], lam_init = ((const float*)(p.ws + OFF_LAM))[l * 2 + 1];
  const float* subg = p.in[16] + l * 64;
  constexpr float LOG2E = 1.4426950408889634f;
  constexpr int NITEMS = 128 + 768 + 768 + 128;
  for (;;) {
    __syncthreads();
    if (tid == 0) *sitem = atomicAdd(ctr, 1);
    __syncthreads();
    const int it = *sitem;
    if (it >= NITEMS) break;
    if (it < 128) {
      const int b = it >> 6, mt = (it & 63) >> 1, nt = it & 1;
      gemm_tile((const bf16*)(p.ws + OFF_DFTL), 8192, (const bf16*)(p.ws + OFF_PQTL) + (size_t)b * 256 * 8192, 8192, 8192, mt * 128, nt * 128, smem,
                [&](int m, int n, float v0, float v1, float v2, float v3) {
                  bf16* y = ymix + (size_t)(8192 + b * 4096 + m) * 1024 + 256 + n;
                  y[0] = f2bf(v0); y[1024] = f2bf(v1); y[2048] = f2bf(v2); y[3072] = f2bf(v3);
                });
    } else if (it >= 1664) {
      const int idx = it - 1664, b = idx >> 2, mt = (idx >> 1) & 1, nt = idx & 1;
      gemm_tile((const bf16*)(p.ws + OFF_DFTC), 512, (const bf16*)(p.ws + OFF_PQTC) + (size_t)b * 256 * 512, 512, 512, mt * 128, nt * 128, smem,
                [&](int m, int n, float v0, float v1, float v2, float v3) {
                  bf16* y = ymix + (size_t)(b * 256 + m) * 1024 + 256 + n;
                  y[0] = f2bf(v0); y[1024] = f2bf(v1); y[2048] = f2bf(v2); y[3072] = f2bf(v3);
                });
    } else {
      const bool lat = it < 896;
      const int idx = lat ? (it - 128) : (it - 896);
      const int type = idx >> 8, rem = idx & 255;
      int b, hd, qb;
      if (lat) { b = rem >> 7; hd = (rem >> 5) & 3; qb = rem & 31; } else { b = rem >> 3; hd = (rem >> 1) & 3; qb = rem & 1; }
      const int tb = lat ? (8192 + b * 4096) : (b * 256);
      const int t0 = tb + qb * 128;
      const int tl0 = t0 - 8192;
      AttnArgs a;
      a.nkeys = lat ? 4608 : 256; a.nsplit = lat ? 4096 : 256; a.vs = a.nkeys;
      f32x16 o0, o1;
      bf16* ydst = ymix + (size_t)(t0 + wave * 32 + r) * 1024;
      if (type == 0) {
        a.c = 0.17677669529663687f * LOG2E;
        a.Vt = (lat ? (const bf16*)(p.ws + OFF_VTDL) + (size_t)((b * 4 + hd) * 64) * 4608 : (const bf16*)(p.ws + OFF_VTDC) + (size_t)((b * 4 + hd) * 64) * 256);
        f32x16 y0, y1;
#pragma unroll 1
        for (int j = 0; j < 2; ++j) {
          const int mp = hd * 2 + j;
          if (lat) { a.Qa = QR + (size_t)tl0 * 512 + mp * 32; a.qsa = 512; a.Qb = Z + (size_t)t0 * ZLD + mp * 32; a.qsb = ZLD; }
          else { a.Qa = Z + (size_t)t0 * ZLD + mp * 32; a.qsa = ZLD; a.Qb = a.Qa; a.qsb = ZLD; }
          a.Ka = Z + (size_t)tb * ZLD + 256 + mp * 32; a.ksa = ZLD;
          a.Kb = (const bf16*)(p.ws + OFF_KDC) + (size_t)(b * 512) * 256 + mp * 32; a.ksb = 256;
          attn_core<32>(a, smem, o0, o1);
          if (j == 0) {
            float* st = (float*)(smem + 28672) + tid;
#pragma unroll
            for (int e = 0; e < 16; ++e) { st[e * 256] = o0[e]; st[(16 + e) * 256] = o1[e]; }
          }
        }
        {
          const float* st = (const float*)(smem + 28672) + tid;
#pragma unroll
          for (int e = 0; e < 16; ++e) { y0[e] = st[e * 256]; y1[e] = st[(16 + e) * 256]; }
        }
        float ss = 0.f;
#pragma unroll
        for (int e = 0; e < 16; ++e) { y0[e] -= lam * o0[e]; y1[e] -= lam * o1[e]; ss += y0[e] * y0[e] + y1[e] * y1[e]; }
        ss += __shfl_xor(ss, 32, 64);
        const float rstd = rsqrtf(ss * (1.f / 64.f) + 1e-6f) * (1.f - lam_init);
#pragma unroll
        for (int e = 0; e < 16; ++e) {
          const int dv = (e & 3) + 8 * (e >> 2) + 4 * h;
          y0[e] *= rstd * subg[dv]; y1[e] *= rstd * subg[32 + dv];
        }
        write_o(ydst + hd * 64, y0, y1, h);
      } else if (type == 1) {
        a.c = 0.10206207261596575f * LOG2E;
        a.Vt = (lat ? (const bf16*)(p.ws + OFF_VTML) + (size_t)((b * 4 + hd) * 64) * 4608 : (const bf16*)(p.ws + OFF_VTMC) + (size_t)((b * 4 + hd) * 64) * 256);
        if (lat) { a.Qa = QMR + (size_t)tl0 * 384 + hd * 96; a.Qb = QMP + (size_t)t0 * 384 + hd * 96; }
        else { a.Qa = QMP + (size_t)t0 * 384 + hd * 96; a.Qb = a.Qa; }
        a.qsa = 384; a.qsb = 384;
        a.Ka = KM + (size_t)tb * 384 + hd * 96; a.ksa = 384;
        a.Kb = KM + (size_t)(16384 + b * 512) * 384 + hd * 96; a.ksb = 384;
        attn_core<96>(a, smem, o0, o1);
        write_o(ydst + 512 + hd * 64, o0, o1, h);
      } else {
        a.c = 0.125f * LOG2E;
        const int kvh = hd >> 1;
        a.Vt = (lat ? (const bf16*)(p.ws + OFF_VTGL) + (size_t)((b * 2 + kvh) * 64) * 4608 : (const bf16*)(p.ws + OFF_VTGC) + (size_t)((b * 2 + kvh) * 64) * 256);
        if (lat) { a.Qa = QR + (size_t)tl0 * 512 + 256 + hd * 64; a.qsa = 512; a.Qb = Z + (size_t)t0 * ZLD + 864 + hd * 64; a.qsb = ZLD; }
        else { a.Qa = Z + (size_t)t0 * ZLD + 864 + hd * 64; a.qsa = ZLD; a.Qb = a.Qa; a.qsb = ZLD; }
        a.Ka = Z + (size_t)tb * ZLD + 1120 + kvh * 64; a.ksa = ZLD;
        a.Kb = (const bf16*)(p.ws + OFF_KGC) + (size_t)(b * 512) * 128 + kvh * 64; a.ksb = 128;
        attn_core<64>(a, smem, o0, o1);
        write_o(ydst + 768 + hd * 64, o0, o1, h);
      }
    }
  }
}

DI void phaseF(const Params& p, int l, char* smem) {
  const bf16* A = (const bf16*)(p.ws + OFF_HBUF);
  const bf16* Bt = (const bf16*)(p.ws + OFF_WOUT) + (size_t)l * 1024 * 1024;
  float* out = p.out;
  for (int it = blockIdx.x; it < 128 * 8; it += gridDim.x) {
    const int mt = it >> 3, nt = it & 7;
    gemm_tile(A, 1024, Bt, 1024, 1024, mt * 128, nt * 128, smem, [&](int m, int n, float v0, float v1, float v2, float v3) {
      const float g1 = modp(p, l, whichmod(m), 2)[n];
      const float vv[4] = {v0, v1, v2, v3};
#pragma unroll
      for (int i = 0; i < 4; ++i) out[(size_t)(m + i) * 1024 + n] = xrow(p, l, m + i)[n] + g1 * vv[i];
    });
  }
}

DI void phaseG(const Params& p, int l) {
  for (int it = blockIdx.x; it < 4096; it += gridDim.x) modnorm_rows(p, l, it, p.in[11] + l * 1024, 3, 4);
}

DI void phaseH(const Params& p, int half, char* smem) {
  const bf16* A = (const bf16*)(p.ws + OFF_HBUF) + (size_t)half * 8192 * 1024;
  const bf16* Bt = (const bf16*)(p.ws + OFF_W1);
  bf16* ab = (bf16*)(p.ws + OFF_A);
  for (int it = blockIdx.x; it < 64 * 32; it += gridDim.x) {
    const int mt = it >> 5, nt = it & 31;
    gemm_tile(A, 1024, Bt, 1024, 1024, mt * 128, nt * 128, smem, [&](int m, int n, float v0, float v1, float v2, float v3) {
      bf16* d = ab + (size_t)m * 4096 + n;
      v0 = fmaxf(v0, 0.f); v1 = fmaxf(v1, 0.f); v2 = fmaxf(v2, 0.f); v3 = fmaxf(v3, 0.f);
      d[0] = f2bf(v0 * v0); d[4096] = f2bf(v1 * v1); d[8192] = f2bf(v2 * v2); d[12288] = f2bf(v3 * v3);
    });
  }
}

DI void phaseI(const Params& p, int l, int half, char* smem) {
  const bf16* A = (const bf16*)(p.ws + OFF_A);
  const bf16* Bt = (const bf16*)(p.ws + OFF_W2);
  float* out = p.out;
  for (int it = blockIdx.x; it < 64 * 8; it += gridDim.x) {
    const int mt = it >> 3, nt = it & 7;
    gemm_tile(A, 4096, Bt, 4096, 4096, mt * 128, nt * 128, smem, [&](int m, int n, float v0, float v1, float v2, float v3) {
      const int t = half * 8192 + m;
      const float g2 = modp(p, l, whichmod(t), 5)[n];
      float* o = out + (size_t)t * 1024 + n;
      o[0] += g2 * v0; o[1024] += g2 * v1; o[2048] += g2 * v2; o[3072] += g2 * v3;
    });
  }
}

DI void phaseZ(const Params& p) {
  const int lane = threadIdx.x & 63, wave = threadIdx.x >> 6;
  const float* g = p.in[26];
  for (int it = blockIdx.x; it < 4096; it += gridDim.x) {
    float* x = p.out + (size_t)(it * 4 + wave) * 1024;
    float4 v[4];
    float ss = 0.f;
#pragma unroll
    for (int i = 0; i < 4; ++i) { v[i] = *(const float4*)(x + lane * 4 + 256 * i); ss += v[i].x * v[i].x + v[i].y * v[i].y + v[i].z * v[i].z + v[i].w * v[i].w; }
    ss = wsum(ss);
    const float rstd = rsqrtf(ss * (1.f / 1024.f) + 1e-6f);
#pragma unroll
    for (int i = 0; i < 4; ++i) {
      const int n = lane * 4 + 256 * i;
      const float4 gg = *(const float4*)(g + n);
      float4 o; o.x = v[i].x * rstd * gg.x; o.y = v[i].y * rstd * gg.y; o.z = v[i].z * rstd * gg.z; o.w = v[i].w * rstd * gg.w;
      *(float4*)(x + n) = o;
    }
  }
}

template <int PH>
DI void run_phase(const Params& p, int l, int half, char* smem) {
  if (PH == 0) phase0(p, smem);
  else if (PH == 1) phaseA(p, l);
  else if (PH == 2) phaseB(p, l, smem);
  else if (PH == 3) phaseC(p, l, smem);
  else if (PH == 4) phaseD(p, l, smem);
  else if (PH == 5) phaseE(p, l, smem);
  else if (PH == 6) phaseF(p, l, smem);
  else if (PH == 7) phaseG(p, l);
  else if (PH == 8) phaseH(p, half, smem);
  else if (PH == 9) phaseI(p, l, half, smem);
  else phaseZ(p);
}

#if MEGA
__global__ void __launch_bounds__(256, 2) mega_kernel(Params p) {
  __shared__ __attribute__((aligned(16))) char smem[SMEM_BYTES];
  cg::grid_group grid = cg::this_grid();
  run_phase<0>(p, 0, 0, smem); grid.sync();
  for (int l = 0; l < 2; ++l) {
    run_phase<1>(p, l, 0, smem); grid.sync();
    run_phase<2>(p, l, 0, smem); grid.sync();
    run_phase<3>(p, l, 0, smem); grid.sync();
    run_phase<4>(p, l, 0, smem); grid.sync();
    run_phase<5>(p, l, 0, smem); grid.sync();
    run_phase<6>(p, l, 0, smem); grid.sync();
    run_phase<7>(p, l, 0, smem); grid.sync();
    for (int half = 0; half < 2; ++half) {
      run_phase<8>(p, l, half, smem); grid.sync();
      run_phase<9>(p, l, half, smem); grid.sync();
    }
  }
  run_phase<10>(p, 0, 0, smem);
}
#else
template <int PH>
__global__ void __launch_bounds__(256, 2) phase_kernel(Params p, int l, int half) {
  __shared__ __attribute__((aligned(16))) char smem[SMEM_BYTES];
  run_phase<PH>(p, l, half, smem);
}
#endif

extern "C" void kernel_launch(void* const* d_in, const int* in_sizes, int n_in, void* d_out, int out_size, void* d_ws, size_t ws_size, hipStream_t stream) {
  Params p{};
  for (int i = 0; i < 27; ++i) p.in[i] = (const float*)d_in[i];
  p.out = (float*)d_out;
  p.ws = (char*)d_ws;
  if (ws_size < OFF_END) { fprintf(stderr, "workspace too small: %zu < %zu\n", ws_size, (size_t)OFF_END); return; }
  hipMemsetAsync(d_ws, 0, 256, stream);
#if MEGA
  static int grid_blocks = 0;
  if (!grid_blocks) {
    int dev = 0, cus = 0, per_cu = 0;
    hipGetDevice(&dev);
    hipDeviceGetAttribute(&cus, hipDeviceAttributeMultiprocessorCount, dev);
    hipOccupancyMaxActiveBlocksPerMultiprocessor(&per_cu, mega_kernel, 256, 0);
    if (per_cu > 2) per_cu = 2;
    grid_blocks = cus * per_cu;
  }
  void* args[] = {&p};
  hipError_t e = hipLaunchCooperativeKernel((void*)mega_kernel, dim3(grid_blocks), dim3(256), args, 0, stream);
  if (e != hipSuccess) fprintf(stderr, "cooperative launch failed: %s (grid %d)\n", hipGetErrorString(e), grid_blocks);
#else
  const int G = 512;
  phase_kernel<0><<<G, 256, 0, stream>>>(p, 0, 0);
  for (int l = 0; l < 2; ++l) {
    phase_kernel<1><<<G, 256, 0, stream>>>(p, l, 0);
    phase_kernel<2><<<G, 256, 0, stream>>>(p, l, 0);
    phase_kernel<3><<<G, 256, 0, stream>>>(p, l, 0);
    phase_kernel<4><<<G, 256, 0, stream>>>(p, l, 0);
    phase_kernel<5><<<G, 256, 0, stream>>>(p, l, 0);
    phase_kernel<6><<<G, 256, 0, stream>>>(p, l, 0);
    phase_kernel<7><<<G, 256, 0, stream>>>(p, l, 0);
    for (int half = 0; half < 2; ++half) {
      phase_kernel<8><<<G, 256, 0, stream>>>(p, l, half);
      phase_kernel<9><<<G, 256, 0, stream>>>(p, l, half);
    }
  }
  phase_kernel<10><<<G, 256, 0, stream>>>(p, 0, 0);
#endif
}
```

```cpp
#include <hip/hip_runtime.h>
#include <hip/hip_cooperative_groups.h>
#include <cstdio>
namespace cg = cooperative_groups;


typedef unsigned short bf16;
typedef __attribute__((ext_vector_type(8))) short bf16x8;
typedef __attribute__((ext_vector_type(16))) float f32x16;
typedef __attribute__((ext_vector_type(2))) float f32x2;
typedef __attribute__((ext_vector_type(4))) unsigned u32x4;
typedef __attribute__((ext_vector_type(2))) __bf16 bf2v;
#define DI __device__ __forceinline__
#define MFMA32(a, b, c) __builtin_amdgcn_mfma_f32_32x32x16_bf16((a), (b), (c), 0, 0, 0)

struct Params { const float* in[27]; float* out; char* ws; };

constexpr size_t OFF_CTR = 0;
constexpr size_t OFF_BAR = 256;
constexpr size_t OFF_MODS = 16384;
constexpr size_t OFF_LAM = OFF_MODS + 2ull * 3 * 6144 * 4;
constexpr size_t OFF_TAB32 = OFF_LAM + 256;
constexpr size_t OFF_TAB64 = OFF_TAB32 + 4096;
constexpr size_t OFF_WIN = OFF_TAB64 + 8192;
constexpr size_t OFF_WOUT = OFF_WIN + 2ull * 2304 * 1024 * 2;
constexpr size_t OFF_WUQ = OFF_WOUT + 2ull * 1024 * 1024 * 2;
constexpr size_t OFF_WUKV = OFF_WUQ + 2ull * 384 * 192 * 2;
constexpr size_t OFF_DFTL = OFF_WUKV + 2ull * 512 * 128 * 2;
constexpr size_t OFF_XRES = OFF_DFTL + 2048ull * 8192 * 2;
constexpr size_t OFF_DFTC = OFF_DFTL + 4096ull * 8192 * 2;
constexpr size_t OFF_W1 = OFF_DFTC + 256ull * 512 * 2;
constexpr size_t OFF_W2 = OFF_W1 + 4096ull * 1024 * 2;
constexpr size_t OFF_HBUF = OFF_W2 + 4096ull * 1024 * 2;
constexpr size_t OFF_R = OFF_HBUF + 16384ull * 1024 * 2;
constexpr size_t OFF_A = OFF_R;
constexpr size_t OFF_Z = OFF_R;
constexpr size_t OFF_QROT = OFF_Z + 17408ull * 1280 * 2;
constexpr size_t OFF_QMP = OFF_QROT + 8192ull * 512 * 2;
constexpr size_t OFF_QMR = OFF_QMP + 16384ull * 384 * 2;
constexpr size_t OFF_KM = OFF_QMR + 8192ull * 384 * 2;
constexpr size_t OFF_VTMC = OFF_KM + 17408ull * 384 * 2;
constexpr size_t OFF_VTML = OFF_VTMC + 32ull * 4 * 64 * 256 * 2;
constexpr size_t OFF_VTDC = OFF_VTML + 2ull * 4 * 64 * 4608 * 2;
constexpr size_t OFF_VTDL = OFF_VTDC + 32ull * 4 * 64 * 256 * 2;
constexpr size_t OFF_VTGC = OFF_VTDL + 2ull * 4 * 64 * 4608 * 2;
constexpr size_t OFF_VTGL = OFF_VTGC + 32ull * 2 * 64 * 256 * 2;
constexpr size_t OFF_PQTC = OFF_VTGL + 2ull * 2 * 64 * 4608 * 2;
constexpr size_t OFF_PQTL = OFF_PQTC + 32ull * 256 * 512 * 2;
constexpr size_t OFF_KDC = OFF_PQTL + 2ull * 256 * 8192 * 2;
constexpr size_t OFF_KGC = OFF_KDC + 2ull * 512 * 256 * 2;
constexpr size_t OFF_END_ATT = OFF_KGC + 2ull * 512 * 128 * 2;
constexpr size_t OFF_END_A = OFF_A + 16384ull * 4096 * 2;
constexpr size_t OFF_END = OFF_END_A > OFF_END_ATT ? OFF_END_A : OFF_END_ATT;

constexpr size_t O_DK = 16777216, O_DV = 20971520, O_CKV = 25165824, O_KR = 27262976, O_GK = 27787264, O_GV = 29884416;

constexpr int NT = 512;
constexpr int SMEM_BYTES = 131072 + 16;
constexpr int ZLD = 1280;

DI int get_tid() { int t = threadIdx.x; asm volatile("" : "+v"(t)); return t; }
DI void gld16(u32x4& r, const void* p) { asm volatile("global_load_dwordx4 %0, %1, off" : "=v"(r) : "v"(p) : "memory"); }
DI unsigned pack2(float a, float b) { f32x2 v = {a, b}; bf2v r = __builtin_convertvector(v, bf2v); return __builtin_bit_cast(unsigned, r); }
DI bf16 f2bf(float a) { return (bf16)(pack2(a, 0.f) & 0xffffu); }
DI float bf2f(bf16 b) { return __uint_as_float(((unsigned)b) << 16); }
template <int CTRL> DI float dpp_f(float v) { return __builtin_bit_cast(float, __builtin_amdgcn_update_dpp(0, __builtin_bit_cast(int, v), CTRL, 0xF, 0xF, true)); }
DI float wsum(float v) {
  v += dpp_f<0xB1>(v);
  v += dpp_f<0x4E>(v);
  v += dpp_f<0x141>(v);
  v += dpp_f<0x140>(v);
  v += __shfl_xor(v, 16, 64);
  v += __shfl_xor(v, 32, 64);
  return v;
}
DI int whichmod(int t) { return t < 8192 ? 0 : 1 + ((t - 8192) >> 12); }
DI const float* xrow(const Params& p, int l, int t) {
  if (l == 0) return t < 8192 ? p.in[0] + (size_t)t * 1024 : p.in[1] + (size_t)(t - 8192) * 1024;
  return p.out + (size_t)t * 1024;
}
DI const float* modp(const Params& p, int l, int w, int i) { return (const float*)(p.ws + OFF_MODS) + ((size_t)(l * 3 + w) * 6 + i) * 1024; }
DI void st4bf(bf16* dst, float a, float b, float c, float d) { uint2 u; u.x = pack2(a, b); u.y = pack2(c, d); *(uint2*)dst = u; }


#define XB_TMO      128
#define XB_XCNT(j)  (256  + 64 * (j))
#define XB_XSUB(j)  (1280 + 64 * (j))
#define XB_XGEN(j)  (2304 + 64 * (j))
#define XB_TOP      3328
#define XB_TOPGEN   3392
#define XB_SPIN_CAP (1u << 22)
#define LAS __attribute__((address_space(3)))
DI unsigned xb_ld(unsigned* p) { return __hip_atomic_load(p, __ATOMIC_RELAXED, __HIP_MEMORY_SCOPE_AGENT); }
DI unsigned xb_add(unsigned* p, unsigned v) { return __hip_atomic_fetch_add(p, v, __ATOMIC_RELAXED, __HIP_MEMORY_SCOPE_AGENT); }
DI unsigned xb_xcc_id() { return (unsigned)__builtin_amdgcn_s_getreg((3 << 11) | 20) & 0xFu; }
#define XB_SPIN(cond, bar) do { unsigned _sp = 0; while (cond) { __builtin_amdgcn_s_sleep(1); \
    if ((++_sp & 255u) == 0u) { if (xb_ld(&(bar)[XB_TMO])) break; if (_sp > XB_SPIN_CAP) { atomicAdd(&(bar)[XB_TMO], 1u); break; } } } } while (0)
struct XcdBarrier { unsigned* bar; unsigned x; volatile LAS unsigned* st; };
DI XcdBarrier xcd_barrier_post(unsigned* bar, volatile LAS unsigned* st) {
  XcdBarrier b; b.bar = bar; b.x = xb_xcc_id(); b.st = st;
  if (threadIdx.x == 0) (void)xb_add(&bar[XB_XCNT(b.x)], 1u);
  return b;
}
DI void xcd_barrier_complete(unsigned* bar, unsigned x, unsigned& nloc, unsigned& nx) {
  const unsigned G = gridDim.x * gridDim.y * gridDim.z;
  unsigned sum, cnt, mine, sp = 0u;
  for (;;) {
    sum = 0u; cnt = 0u; mine = 0u;
#pragma unroll
    for (unsigned j = 0; j < 16; ++j) { const unsigned c = xb_ld(&bar[XB_XCNT(j)]); sum += c; cnt += (c > 0u) ? 1u : 0u; mine = (j == x) ? c : mine; }
    if (sum == G) break;
    __builtin_amdgcn_s_sleep(1);
    if ((++sp & 255u) == 0u) { if (xb_ld(&bar[XB_TMO])) break; if (sp > XB_SPIN_CAP) { atomicAdd(&bar[XB_TMO], 1u); break; } }
  }
  nloc = mine > 0u ? mine : 1u; nx = cnt > 0u ? cnt : 1u;
}
DI void xcd_barrier(const XcdBarrier& b) {
  asm volatile("s_waitcnt vmcnt(0)" ::: "memory");
  __syncthreads();
  if (threadIdx.x == 0) {
    unsigned* bar = b.bar;
    __builtin_amdgcn_s_waitcnt(0);
    unsigned nloc = b.st[0], nx = b.st[1];
    if (nloc == 0u) { xcd_barrier_complete(bar, b.x, nloc, nx); b.st[0] = nloc; b.st[1] = nx; }
    const unsigned old = xb_add(&bar[XB_XSUB(b.x)], 1u);
    const unsigned gen = old / nloc;
    if (old + 1u == (gen + 1u) * nloc) {
      __builtin_amdgcn_fence(__ATOMIC_RELEASE, "agent");
      asm volatile("s_waitcnt vmcnt(0)" ::: "memory");
      const unsigned og = xb_add(&bar[XB_TOP], 1u);
      const unsigned tg = og / nx;
      if (og + 1u == (tg + 1u) * nx) xb_add(&bar[XB_TOPGEN], 1u);
      else XB_SPIN(xb_ld(&bar[XB_TOPGEN]) == tg, bar);
      __builtin_amdgcn_fence(__ATOMIC_ACQUIRE, "agent");
      xb_add(&bar[XB_XGEN(b.x)], 1u);
      asm volatile("s_waitcnt vmcnt(0)" ::: "memory");
    } else {
      XB_SPIN(xb_ld(&bar[XB_XGEN(b.x)]) == gen, bar);
      __builtin_amdgcn_fence(__ATOMIC_ACQUIRE, "agent");
      asm volatile("s_waitcnt vmcnt(0)" ::: "memory");
    }
  }
  __syncthreads();
}

template <class Epi>
DI void gemm_tile(const bf16* __restrict__ A, int lda, const bf16* __restrict__ Bt, int ldb, int K, int m0, int n0, char* smem, Epi epi) {
  bf16* As = (bf16*)smem;
  bf16* Bs = As + 2 * 256 * 72;
  const int tid = get_tid(), lane = tid & 63, wave = tid >> 6;
  const int r = lane & 31, h = lane >> 5, wm = wave >> 1, wn = wave & 1;
  const int lr = tid >> 3, lc = (tid & 7) * 8;
  const bf16* ag = A + (size_t)(m0 + lr) * lda + lc;
  const bf16* bg = Bt + (size_t)(n0 + lr) * ldb + lc;
  f32x16 acc[2][2];
#pragma unroll
  for (int i = 0; i < 2; ++i)
#pragma unroll
    for (int j = 0; j < 2; ++j)
#pragma unroll
      for (int e = 0; e < 16; ++e) acc[i][j][e] = 0.f;
  u32x4 ra0, ra1, ra2, ra3, rb0, rb1;
  const bf16* ag1 = ag + (size_t)64 * lda; const bf16* ag2 = ag + (size_t)128 * lda; const bf16* ag3 = ag + (size_t)192 * lda;
  const bf16* bg1 = bg + (size_t)64 * ldb;
  bf16* asw = As + lr * 72 + lc;
  bf16* bsw = Bs + lr * 72 + lc;
  __syncthreads();
  ra0 = *(const u32x4*)ag; ra1 = *(const u32x4*)ag1; ra2 = *(const u32x4*)ag2; ra3 = *(const u32x4*)ag3;
  rb0 = *(const u32x4*)bg; rb1 = *(const u32x4*)bg1;
  *(u32x4*)(asw) = ra0; *(u32x4*)(asw + 64 * 72) = ra1; *(u32x4*)(asw + 128 * 72) = ra2; *(u32x4*)(asw + 192 * 72) = ra3;
  *(u32x4*)(bsw) = rb0; *(u32x4*)(bsw + 64 * 72) = rb1;
  const int nk = K >> 6;
  if (nk > 1) { gld16(ra0, ag + 64); gld16(rb0, bg + 64); gld16(ra1, ag1 + 64); gld16(rb1, bg1 + 64); gld16(ra2, ag2 + 64); gld16(ra3, ag3 + 64); }
  __syncthreads();
  for (int kt = 0; kt < nk; ++kt) {
    const int buf = kt & 1;
    if (kt + 1 < nk) {
      asm volatile("s_waitcnt vmcnt(0)" : "+v"(ra0), "+v"(ra1), "+v"(ra2), "+v"(ra3), "+v"(rb0), "+v"(rb1) : : "memory");
      const int nba = (buf ^ 1) * 256 * 72, nbb = (buf ^ 1) * 128 * 72;
      *(u32x4*)(asw + nba) = ra0; *(u32x4*)(asw + nba + 64 * 72) = ra1; *(u32x4*)(asw + nba + 128 * 72) = ra2; *(u32x4*)(asw + nba + 192 * 72) = ra3;
      *(u32x4*)(bsw + nbb) = rb0; *(u32x4*)(bsw + nbb + 64 * 72) = rb1;
      if (kt + 2 < nk) {
        const int k0 = (kt + 2) << 6;
        gld16(ra0, ag + k0); gld16(rb0, bg + k0); gld16(ra1, ag1 + k0); gld16(rb1, bg1 + k0); gld16(ra2, ag2 + k0); gld16(ra3, ag3 + k0);
      }
    }
    const bf16* as = As + (buf * 256 + wm * 64 + r) * 72 + 8 * h;
    const bf16* bs = Bs + (buf * 128 + wn * 64 + r) * 72 + 8 * h;
#pragma unroll
    for (int ks = 0; ks < 4; ++ks) {
      bf16x8 a0 = *(const bf16x8*)(as + ks * 16), a1 = *(const bf16x8*)(as + 32 * 72 + ks * 16);
      bf16x8 b0 = *(const bf16x8*)(bs + ks * 16), b1 = *(const bf16x8*)(bs + 32 * 72 + ks * 16);
      acc[0][0] = MFMA32(a0, b0, acc[0][0]);
      acc[0][1] = MFMA32(a0, b1, acc[0][1]);
      acc[1][0] = MFMA32(a1, b0, acc[1][0]);
      acc[1][1] = MFMA32(a1, b1, acc[1][1]);
    }
    __syncthreads();
  }
#pragma unroll
  for (int i = 0; i < 2; ++i)
#pragma unroll
    for (int j = 0; j < 2; ++j)
#pragma unroll
      for (int g = 0; g < 4; ++g) {
        const int m = m0 + wm * 64 + i * 32 + 8 * g + 4 * h;
        const int n = n0 + wn * 64 + j * 32 + r;
        epi(m, n, acc[i][j][4 * g], acc[i][j][4 * g + 1], acc[i][j][4 * g + 2], acc[i][j][4 * g + 3]);
      }
}

template <class Epi>
DI void gemm_tile_n64(const bf16* __restrict__ A, int lda, const bf16* __restrict__ Bt, int ldb, int K, int m0, int n0, char* smem, Epi epi) {
  bf16* As = (bf16*)smem;
  bf16* Bs = As + 2 * 256 * 72;
  const int tid = get_tid(), lane = tid & 63, wave = tid >> 6;
  const int r = lane & 31, h = lane >> 5, wm = wave >> 1, wn = wave & 1;
  const int lr = tid >> 3, lc = (tid & 7) * 8;
  const bf16* ag = A + (size_t)(m0 + lr) * lda + lc;
  const bf16* bg = Bt + (size_t)(n0 + lr) * ldb + lc;
  f32x16 acc[2];
#pragma unroll
  for (int i = 0; i < 2; ++i)
#pragma unroll
    for (int e = 0; e < 16; ++e) acc[i][e] = 0.f;
  u32x4 ra0, ra1, ra2, ra3, rb0;
  const bf16* ag1 = ag + (size_t)64 * lda; const bf16* ag2 = ag + (size_t)128 * lda; const bf16* ag3 = ag + (size_t)192 * lda;
  bf16* asw = As + lr * 72 + lc;
  bf16* bsw = Bs + lr * 72 + lc;
  __syncthreads();
  ra0 = *(const u32x4*)ag; ra1 = *(const u32x4*)ag1; ra2 = *(const u32x4*)ag2; ra3 = *(const u32x4*)ag3; rb0 = *(const u32x4*)bg;
  *(u32x4*)(asw) = ra0; *(u32x4*)(asw + 64 * 72) = ra1; *(u32x4*)(asw + 128 * 72) = ra2; *(u32x4*)(asw + 192 * 72) = ra3; *(u32x4*)(bsw) = rb0;
  const int nk = K >> 6;
  if (nk > 1) { gld16(ra0, ag + 64); gld16(rb0, bg + 64); gld16(ra1, ag1 + 64); gld16(ra2, ag2 + 64); gld16(ra3, ag3 + 64); }
  __syncthreads();
  for (int kt = 0; kt < nk; ++kt) {
    const int buf = kt & 1;
    if (kt + 1 < nk) {
      asm volatile("s_waitcnt vmcnt(0)" : "+v"(ra0), "+v"(ra1), "+v"(ra2), "+v"(ra3), "+v"(rb0) : : "memory");
      const int nba = (buf ^ 1) * 256 * 72, nbb = (buf ^ 1) * 64 * 72;
      *(u32x4*)(asw + nba) = ra0; *(u32x4*)(asw + nba + 64 * 72) = ra1; *(u32x4*)(asw + nba + 128 * 72) = ra2; *(u32x4*)(asw + nba + 192 * 72) = ra3;
      *(u32x4*)(bsw + nbb) = rb0;
      if (kt + 2 < nk) {
        const int k0 = (kt + 2) << 6;
        gld16(ra0, ag + k0); gld16(rb0, bg + k0); gld16(ra1, ag1 + k0); gld16(ra2, ag2 + k0); gld16(ra3, ag3 + k0);
      }
    }
    const bf16* as = As + (buf * 256 + wm * 64 + r) * 72 + 8 * h;
    const bf16* bs = Bs + (buf * 64 + wn * 32 + r) * 72 + 8 * h;
#pragma unroll
    for (int ks = 0; ks < 4; ++ks) {
      bf16x8 a0 = *(const bf16x8*)(as + ks * 16), a1 = *(const bf16x8*)(as + 32 * 72 + ks * 16);
      bf16x8 b0 = *(const bf16x8*)(bs + ks * 16);
      acc[0] = MFMA32(a0, b0, acc[0]);
      acc[1] = MFMA32(a1, b0, acc[1]);
    }
    __syncthreads();
  }
#pragma unroll
  for (int i = 0; i < 2; ++i)
#pragma unroll
    for (int g = 0; g < 4; ++g) {
      const int m = m0 + wm * 64 + i * 32 + 8 * g + 4 * h;
      const int n = n0 + wn * 32 + r;
      epi(m, n, acc[i][4 * g], acc[i][4 * g + 1], acc[i][4 * g + 2], acc[i][4 * g + 3]);
    }
}

template <class Epi>
DI void gemm_tile_dual(const bf16* __restrict__ A, int lda, const bf16* __restrict__ Bt, int ldb, int K, int m0, int n0, char* smem, Epi epi) {
  bf16* As = (bf16*)smem;
  bf16* Bs = As + 2 * 256 * 72;
  const int tid = get_tid(), lane = tid & 63, wave = tid >> 6;
  const int r = lane & 31, h = lane >> 5, wm = wave >> 1, wn = wave & 1;
  const int lr = tid >> 3, lc = (tid & 7) * 8;
  const bf16* ag = A + (size_t)(m0 + lr) * lda + lc;
  const bf16* bg = Bt + (size_t)(n0 + lr) * ldb + lc;
  f32x16 accC[2][2], accS[2][2];
#pragma unroll
  for (int i = 0; i < 2; ++i)
#pragma unroll
    for (int j = 0; j < 2; ++j)
#pragma unroll
      for (int e = 0; e < 16; ++e) { accC[i][j][e] = 0.f; accS[i][j][e] = 0.f; }
  u32x4 ra0, ra1, ra2, ra3, rb0, rb1;
  const bf16* ag1 = ag + (size_t)64 * lda; const bf16* ag2 = ag + (size_t)128 * lda; const bf16* ag3 = ag + (size_t)192 * lda;
  const bf16* bg1 = bg + (size_t)64 * ldb;
  bf16* asw = As + lr * 72 + lc;
  bf16* bsw = Bs + lr * 72 + lc;
  __syncthreads();
  ra0 = *(const u32x4*)ag; ra1 = *(const u32x4*)ag1; ra2 = *(const u32x4*)ag2; ra3 = *(const u32x4*)ag3;
  rb0 = *(const u32x4*)bg; rb1 = *(const u32x4*)bg1;
  *(u32x4*)(asw) = ra0; *(u32x4*)(asw + 64 * 72) = ra1; *(u32x4*)(asw + 128 * 72) = ra2; *(u32x4*)(asw + 192 * 72) = ra3;
  *(u32x4*)(bsw) = rb0; *(u32x4*)(bsw + 64 * 72) = rb1;
  const int nk = K >> 6;
  if (nk > 1) { gld16(ra0, ag + 64); gld16(rb0, bg + 64); gld16(ra1, ag1 + 64); gld16(rb1, bg1 + 64); gld16(ra2, ag2 + 64); gld16(ra3, ag3 + 64); }
  __syncthreads();
  auto step = [&](int kt, f32x16 (&acc)[2][2]) {
    const int buf = kt & 1;
    if (kt + 1 < nk) {
      asm volatile("s_waitcnt vmcnt(0)" : "+v"(ra0), "+v"(ra1), "+v"(ra2), "+v"(ra3), "+v"(rb0), "+v"(rb1) : : "memory");
      const int nba = (buf ^ 1) * 256 * 72, nbb = (buf ^ 1) * 128 * 72;
      *(u32x4*)(asw + nba) = ra0; *(u32x4*)(asw + nba + 64 * 72) = ra1; *(u32x4*)(asw + nba + 128 * 72) = ra2; *(u32x4*)(asw + nba + 192 * 72) = ra3;
      *(u32x4*)(bsw + nbb) = rb0; *(u32x4*)(bsw + nbb + 64 * 72) = rb1;
      if (kt + 2 < nk) {
        const int k0 = (kt + 2) << 6;
        gld16(ra0, ag + k0); gld16(rb0, bg + k0); gld16(ra1, ag1 + k0); gld16(rb1, bg1 + k0); gld16(ra2, ag2 + k0); gld16(ra3, ag3 + k0);
      }
    }
    const bf16* as = As + (buf * 256 + wm * 64 + r) * 72 + 8 * h;
    const bf16* bs = Bs + (buf * 128 + wn * 64 + r) * 72 + 8 * h;
#pragma unroll
    for (int ks = 0; ks < 4; ++ks) {
      bf16x8 a0 = *(const bf16x8*)(as + ks * 16), a1 = *(const bf16x8*)(as + 32 * 72 + ks * 16);
      bf16x8 b0 = *(const bf16x8*)(bs + ks * 16), b1 = *(const bf16x8*)(bs + 32 * 72 + ks * 16);
      acc[0][0] = MFMA32(a0, b0, acc[0][0]);
      acc[0][1] = MFMA32(a0, b1, acc[0][1]);
      acc[1][0] = MFMA32(a1, b0, acc[1][0]);
      acc[1][1] = MFMA32(a1, b1, acc[1][1]);
    }
    __syncthreads();
  };
  for (int kt = 0; kt < (nk >> 1); ++kt) step(kt, accC);
  for (int kt = (nk >> 1); kt < nk; ++kt) step(kt, accS);
#pragma unroll
  for (int i = 0; i < 2; ++i)
#pragma unroll
    for (int j = 0; j < 2; ++j)
#pragma unroll
      for (int g = 0; g < 4; ++g) {
        const int m = m0 + wm * 64 + i * 32 + 8 * g + 4 * h;
        const int n = n0 + wn * 64 + j * 32 + r;
#pragma unroll
        for (int q = 0; q < 4; ++q) epi(m + q, n, accC[i][j][4 * g + q], accS[i][j][4 * g + q]);
      }
}

namespace pg8 {
typedef float f32x4 __attribute__((ext_vector_type(4)));
constexpr int BM = 256, BK = 64, HALF = 128, HTB = HALF * BK * 2, NXCD = 8, WGM = 8;
DI int lds_byte(int r, int c) { const int st = (r >> 4) * 2 + (c >> 5), rr = r & 15, cc = c & 31, ob = rr * 64 + cc * 2; return st * 1024 + (ob ^ (((ob >> 9) & 1) << 5)); }
DI void stage_rc(int b, int& R, int& C) { const int st = b / 1024, sb = b % 1024, swz = sb ^ (((sb >> 9) & 1) << 5); R = (st >> 1) * 16 + swz / 64; C = (st & 1) * 32 + (swz % 64) / 2; }
DI int perm32(int rho) { const int n = rho >> 4, i = rho & 15; return 8 * (i >> 2) + 4 * n + (i & 3); }
struct Unit { int pm, pn; };
struct StaticOrder {
  int nM, nN, nwg, G, c;
  DI void init(int M, int N, int G_, int c_) { nM = M / BM; nN = N / BM; nwg = nM * nN; G = G_; c = c_; }
  DI bool next(int i, Unit& u) const {
    const long L = (long)i * G + c; if (L >= nwg) return false;
    int wgid = (int)L; { const int q = nwg / NXCD, r = nwg % NXCD, xcd = wgid % NXCD, off = wgid / NXCD; wgid = (xcd < r ? xcd * (q + 1) : r * (q + 1) + (xcd - r) * q) + off; }
    const int nig = WGM * nN, gid = wgid / nig, fm = gid * WGM, gsz = (nM - fm) < WGM ? (nM - fm) : WGM;
    u.pm = fm + ((wgid % nig) % gsz); u.pn = (wgid % nig) / gsz; return true;
  }
};
template <bool PERM, class Epi>
DI void gemm_phase(LAS unsigned char* lds, const bf16* gA, const bf16* gBt, int M, int N, int K, const Epi& E) {
  const int tid = get_tid(), wid = __builtin_amdgcn_readfirstlane(tid >> 6), lane = tid & 63, wr = wid >> 2, wc = wid & 3, fr = lane & 15, fq = lane >> 4;
  const int nt = K / BK;
  StaticOrder S; S.init(M, N, gridDim.x, blockIdx.x);
  unsigned voffA[2], voffB[2];
#pragma unroll
  for (int i = 0; i < 2; ++i) { int R, C; stage_rc(tid * 16 + i * 8192, R, C); const int Rb = PERM ? ((R & ~31) + perm32(R & 31)) : R;
    voffA[i] = (unsigned)(R * K + C) * 2u; voffB[i] = (unsigned)(Rb * K + C) * 2u; }
  const size_t kstep = (size_t)(BK * 2);
  const size_t hstep = (size_t)HALF * K * 2;
  const size_t tstep = 2 * hstep;
  const unsigned ldsw = (unsigned)wid * 1024u;
  const int aoff = lds_byte(wr * 64 + fr, fq * 8), boff = lds_byte(wc * 32 + fr, fq * 8);
#define PG8_SA(b, h) (((b) * 2 + (h)) * HTB)
#define PG8_SB(b, h) ((4 + (b) * 2 + (h)) * HTB)
#define PG8_STAGE(bufoff, gbase, voff) do { _Pragma("unroll") for (int _i = 0; _i < 2; ++_i) \
    __builtin_amdgcn_global_load_lds((const unsigned*)((const char*)(gbase) + (voff)[_i]), (LAS unsigned*)(lds + (bufoff) + ldsw + _i * 8192), 16, 0, 0); } while (0)
#define PG8_LDA(dst, b, h) do { _Pragma("unroll") for (int m = 0; m < 4; ++m) _Pragma("unroll") for (int k = 0; k < 2; ++k) dst[m][k] = *(const LAS bf16x8*)(lds + PG8_SA(b, h) + aoff + m * 2048 + k * 1024); } while (0)
#define PG8_LDB(dst, b, h) do { _Pragma("unroll") for (int n = 0; n < 2; ++n) _Pragma("unroll") for (int k = 0; k < 2; ++k) dst[n][k] = *(const LAS bf16x8*)(lds + PG8_SB(b, h) + boff + n * 2048 + k * 1024); } while (0)
#define PG8_MMA(ai, bj, At, Bt) do { __builtin_amdgcn_s_setprio(1); _Pragma("unroll") for (int m = 0; m < 4; ++m) _Pragma("unroll") for (int n = 0; n < 2; ++n) _Pragma("unroll") for (int k = 0; k < 2; ++k) \
    acc[ai][bj][m][n] = __builtin_amdgcn_mfma_f32_16x16x32_bf16(Bt[n][k], At[m][k], acc[ai][bj][m][n], 0, 0, 0); __builtin_amdgcn_s_setprio(0); } while (0)
#define PG8_WAIT_V(n) asm volatile("s_waitcnt vmcnt(" #n ")" ::: "memory")
#define PG8_WAIT_L(n) asm volatile("s_waitcnt lgkmcnt(" #n ")" ::: "memory")
#define PG8_BAR __builtin_amdgcn_s_barrier()
#define PG8_SCHED __builtin_amdgcn_sched_barrier(0)
  Unit cur, nxt; int ui = 0;
  if (!S.next(0, cur)) return;
  f32x4 acc[2][2][4][2];
#pragma unroll
  for (int a = 0; a < 2; ++a)
#pragma unroll
    for (int b = 0; b < 2; ++b)
#pragma unroll
      for (int m = 0; m < 4; ++m)
#pragma unroll
        for (int n = 0; n < 2; ++n) acc[a][b][m][n] = (f32x4){0.f, 0.f, 0.f, 0.f};
  bf16x8 At[4][2], B0[2][2], B1[2][2];
  const char* cA = (const char*)gA + (size_t)cur.pm * tstep; const char* cB = (const char*)gBt + (size_t)cur.pn * tstep;
  PG8_STAGE(PG8_SB(0, 0), cB, voffB); PG8_STAGE(PG8_SA(0, 0), cA, voffA); PG8_STAGE(PG8_SB(0, 1), cB + hstep, voffB); PG8_STAGE(PG8_SA(0, 1), cA + hstep, voffA);
  if (wr == 1) PG8_BAR;
  PG8_WAIT_V(4); PG8_BAR;
  PG8_STAGE(PG8_SB(1, 0), cB + kstep, voffB); PG8_STAGE(PG8_SA(1, 0), cA + kstep, voffA); PG8_STAGE(PG8_SB(1, 1), cB + hstep + kstep, voffB);
  PG8_WAIT_V(6); PG8_BAR;
  for (;;) {
    const bool has_next = S.next(ui + 1, nxt);
    const char* nA = has_next ? (const char*)gA + (size_t)nxt.pm * tstep : cA; const char* nB = has_next ? (const char*)gBt + (size_t)nxt.pn * tstep : cB;
    for (int t = 0; t < nt; t += 2) {
      const bool last = (t == nt - 2);
      const char* a1 = cA + (size_t)(t + 1) * kstep;
      const char* a2 = last ? nA : cA + (size_t)(t + 2) * kstep; const char* b2 = last ? nB : cB + (size_t)(t + 2) * kstep;
      const char* a3 = a2 + kstep; const char* b3 = b2 + kstep;
      PG8_LDB(B0, 0, 0); PG8_SCHED; PG8_LDA(At, 0, 0); PG8_STAGE(PG8_SA(1, 1), a1 + hstep, voffA);
      PG8_WAIT_L(8); PG8_BAR; PG8_WAIT_L(0); PG8_MMA(0, 0, At, B0); PG8_BAR; PG8_SCHED;
      PG8_LDB(B1, 0, 1); PG8_STAGE(PG8_SB(0, 0), b2, voffB);
      PG8_BAR; PG8_WAIT_L(0); PG8_MMA(0, 1, At, B1); PG8_BAR;
      PG8_LDA(At, 0, 1); PG8_STAGE(PG8_SA(0, 0), a2, voffA);
      PG8_BAR; PG8_WAIT_L(0); PG8_MMA(1, 0, At, B0); PG8_BAR; PG8_SCHED;
      PG8_STAGE(PG8_SB(0, 1), b2 + hstep, voffB);
      PG8_WAIT_V(6); PG8_BAR; PG8_MMA(1, 1, At, B1); PG8_BAR;
      PG8_LDB(B0, 1, 0); PG8_SCHED; PG8_LDA(At, 1, 0); PG8_STAGE(PG8_SA(0, 1), a2 + hstep, voffA);
      PG8_WAIT_L(8); PG8_BAR; PG8_WAIT_L(0); PG8_MMA(0, 0, At, B0); PG8_BAR; PG8_SCHED;
      PG8_LDB(B1, 1, 1); PG8_STAGE(PG8_SB(1, 0), b3, voffB);
      PG8_BAR; PG8_WAIT_L(0); PG8_MMA(0, 1, At, B1); PG8_BAR;
      PG8_LDA(At, 1, 1); PG8_STAGE(PG8_SA(1, 0), a3, voffA);
      PG8_BAR; PG8_WAIT_L(0); PG8_MMA(1, 0, At, B0); PG8_BAR; PG8_SCHED;
      PG8_STAGE(PG8_SB(1, 1), b3 + hstep, voffB);
      PG8_WAIT_V(6); PG8_BAR; PG8_MMA(1, 1, At, B1); PG8_BAR;
    }
    E(acc, cur, wr, wc, fr, fq);
    if (!has_next) break;
#pragma unroll
    for (int a = 0; a < 2; ++a)
#pragma unroll
      for (int b = 0; b < 2; ++b)
#pragma unroll
        for (int m = 0; m < 4; ++m)
#pragma unroll
          for (int n = 0; n < 2; ++n) acc[a][b][m][n] = (f32x4){0.f, 0.f, 0.f, 0.f};
    cur = nxt; cA = nA; cB = nB; ++ui;
  }
  PG8_WAIT_V(0);
  if (wr == 0) PG8_BAR;
  PG8_BAR;
#undef PG8_SA
#undef PG8_SB
#undef PG8_STAGE
#undef PG8_LDA
#undef PG8_LDB
#undef PG8_MMA
#undef PG8_WAIT_V
#undef PG8_WAIT_L
#undef PG8_BAR
#undef PG8_SCHED
}
}

struct AttnArgs {
  const bf16 *Qa, *Qb, *Ka, *Kb, *Vt;
  int qsa, qsb, ksa, ksb, vs, nkeys, nsplit;
  float c;
};

DI void softmax_tile(f32x16& s0, f32x16& s1, float& mrun, float& lrun, f32x16& o0, f32x16& o1, float c) {
  float mx = s0[0];
#pragma unroll
  for (int e = 1; e < 16; ++e) mx = fmaxf(mx, s0[e]);
#pragma unroll
  for (int e = 0; e < 16; ++e) mx = fmaxf(mx, s1[e]);
  mx = fmaxf(mx, __shfl_xor(mx, 32, 64));
  const float mt = mx * c;
  float mnew = mrun;
  if (__builtin_amdgcn_ballot_w64(mt > mrun + 8.f) != 0ull) {
    mnew = fmaxf(mrun, mt);
    const float alpha = __builtin_amdgcn_exp2f(mrun - mnew);
    const f32x2 aa = {alpha, alpha};
    lrun *= alpha;
#pragma unroll
    for (int e = 0; e < 8; ++e) {
      f32x2 a0 = {o0[2 * e], o0[2 * e + 1]}, a1 = {o1[2 * e], o1[2 * e + 1]};
      a0 *= aa; a1 *= aa;
      o0[2 * e] = a0.x; o0[2 * e + 1] = a0.y; o1[2 * e] = a1.x; o1[2 * e + 1] = a1.y;
    }
    mrun = mnew;
  }
  const f32x2 cc = {c, c}, mm = {-mnew, -mnew};
  f32x2 ps = {0.f, 0.f};
#pragma unroll
  for (int e = 0; e < 8; ++e) {
    f32x2 t = {s0[2 * e], s0[2 * e + 1]};
    t = t * cc + mm;
    t.x = __builtin_amdgcn_exp2f(t.x); t.y = __builtin_amdgcn_exp2f(t.y);
    s0[2 * e] = t.x; s0[2 * e + 1] = t.y;
    ps += t;
  }
#pragma unroll
  for (int e = 0; e < 8; ++e) {
    f32x2 t = {s1[2 * e], s1[2 * e + 1]};
    t = t * cc + mm;
    t.x = __builtin_amdgcn_exp2f(t.x); t.y = __builtin_amdgcn_exp2f(t.y);
    s1[2 * e] = t.x; s1[2 * e + 1] = t.y;
    ps += t;
  }
  lrun += ps.x + ps.y;
}

DI void pv_tile(const f32x16& s0, const f32x16& s1, const bf16* vp, f32x16& o0, f32x16& o1) {
#pragma unroll
  for (int s = 0; s < 2; ++s) {
    uint4 u;
    u.x = pack2(s0[8 * s], s0[8 * s + 1]); u.y = pack2(s0[8 * s + 2], s0[8 * s + 3]);
    u.z = pack2(s0[8 * s + 4], s0[8 * s + 5]); u.w = pack2(s0[8 * s + 6], s0[8 * s + 7]);
    bf16x8 pf = __builtin_bit_cast(bf16x8, u);
    bf16x8 v0 = *(const bf16x8*)(vp + 16 * s), v1 = *(const bf16x8*)(vp + 32 * 72 + 16 * s);
    o0 = MFMA32(v0, pf, o0);
    o1 = MFMA32(v1, pf, o1);
  }
#pragma unroll
  for (int s = 0; s < 2; ++s) {
    uint4 u;
    u.x = pack2(s1[8 * s], s1[8 * s + 1]); u.y = pack2(s1[8 * s + 2], s1[8 * s + 3]);
    u.z = pack2(s1[8 * s + 4], s1[8 * s + 5]); u.w = pack2(s1[8 * s + 6], s1[8 * s + 7]);
    bf16x8 pf = __builtin_bit_cast(bf16x8, u);
    bf16x8 v0 = *(const bf16x8*)(vp + 32 + 16 * s), v1 = *(const bf16x8*)(vp + 32 * 72 + 32 + 16 * s);
    o0 = MFMA32(v0, pf, o0);
    o1 = MFMA32(v1, pf, o1);
  }
}

template <int DQK>
DI void attn_core(const AttnArgs& a, char* smem, f32x16& o0, f32x16& o1) {
  constexpr int NS = DQK / 16;
  constexpr int KROW = DQK + 8;
  constexpr int KCH = DQK / 8;
  bf16* Ks = (bf16*)smem;
  bf16* Vs = Ks + 2 * 64 * KROW;
  const int tid = get_tid(), lane = tid & 63, wave = tid >> 6;
  const int r = lane & 31, h = lane >> 5;
  const int pr = (r & ~12) | ((r & 4) << 1) | ((r & 8) >> 1);
  bf16x8 qf[NS];
  {
    const bf16* qp = a.Qa + (size_t)(wave * 32 + r) * a.qsa + 8 * h;
#pragma unroll
    for (int s = 0; s < NS; ++s) qf[s] = *(const bf16x8*)(qp + s * 16);
  }
#pragma unroll
  for (int e = 0; e < 16; ++e) { o0[e] = 0.f; o1[e] = 0.f; }
  float mrun = -1e30f, lrun = 0.f;
  u32x4 rk0 = {0u, 0u, 0u, 0u}, rk1 = rk0, rv0 = rk0;
  const int nt = a.nkeys >> 6;
  constexpr int NKC = 64 * KCH;
  const int krow0 = tid / KCH, kch0 = tid % KCH, krow1 = (tid + 512) / KCH, kch1 = (tid + 512) % KCH;
  const int vrow0 = tid >> 3, vch = tid & 7;
  const bool k0on = tid < NKC, k1on = (NKC > 512) && (tid + 512 < NKC);
  auto gload = [&](int kt) {
    const int key0 = kt << 6;
    const bf16* kb; int ks;
    if (key0 < a.nsplit) { kb = a.Ka + (size_t)key0 * a.ksa; ks = a.ksa; } else { kb = a.Kb + (size_t)(key0 - a.nsplit) * a.ksb; ks = a.ksb; }
    if (k0on) gld16(rk0, kb + (size_t)krow0 * ks + kch0 * 8);
    if (k1on) gld16(rk1, kb + (size_t)krow1 * ks + kch1 * 8);
    gld16(rv0, a.Vt + (size_t)vrow0 * a.vs + key0 + vch * 8);
  };
  auto sstore = [&](int buf) {
    if (k0on) *(u32x4*)(Ks + (buf * 64 + krow0) * KROW + kch0 * 8) = rk0;
    if (k1on) *(u32x4*)(Ks + (buf * 64 + krow1) * KROW + kch1 * 8) = rk1;
    *(u32x4*)(Vs + (buf * 64 + vrow0) * 72 + vch * 8) = rv0;
  };
  __syncthreads();
  gload(0);
  asm volatile("s_waitcnt vmcnt(0)" : "+v"(rk0), "+v"(rk1), "+v"(rv0) : : "memory");
  sstore(0);
  __syncthreads();
  for (int kt = 0; kt < nt; ++kt) {
    const int buf = kt & 1;
    gload(kt + 1 < nt ? kt + 1 : kt);
    if ((kt << 6) == a.nsplit) {
      const bf16* qp = a.Qb + (size_t)(wave * 32 + r) * a.qsb + 8 * h;
#pragma unroll
      for (int s = 0; s < NS; ++s) qf[s] = *(const bf16x8*)(qp + s * 16);
    }
    f32x16 s0, s1;
#pragma unroll
    for (int e = 0; e < 16; ++e) { s0[e] = 0.f; s1[e] = 0.f; }
    const bf16* kp = Ks + (buf * 64 + pr) * KROW + 8 * h;
#pragma unroll
    for (int s = 0; s < NS; ++s) {
      bf16x8 k0 = *(const bf16x8*)(kp + s * 16), k1 = *(const bf16x8*)(kp + 32 * KROW + s * 16);
      s0 = MFMA32(k0, qf[s], s0);
      s1 = MFMA32(k1, qf[s], s1);
    }
    const bf16* vp = Vs + (buf * 64 + r) * 72 + 8 * h;
    softmax_tile(s0, s1, mrun, lrun, o0, o1, a.c);
    pv_tile(s0, s1, vp, o0, o1);
    asm volatile("s_waitcnt vmcnt(0)" : "+v"(rk0), "+v"(rk1), "+v"(rv0) : : "memory");
    sstore(buf ^ 1);
    __syncthreads();
  }
  const float ltot = lrun + __shfl_xor(lrun, 32, 64);
  const float inv = 1.f / ltot;
#pragma unroll
  for (int e = 0; e < 16; ++e) { o0[e] *= inv; o1[e] *= inv; }
}


struct AttnArgs2 {
  const bf16 *QaA, *QbA, *QaB, *QbB;
  const bf16 *Ka, *Kb, *Vt;
  int qsa, qsb, ksa, ksb, vs, nkeys, nsplit;
  float c;
};

template <int DQK, bool KSPLIT>
DI void attn_dual(const AttnArgs2& a, char* smem, f32x16& oA0, f32x16& oA1, f32x16& oB0, f32x16& oB1) {
  constexpr int NS = DQK / 16;
  constexpr int KW = KSPLIT ? 2 * DQK : DQK;
  constexpr int KROW = KW + 8;
  constexpr int KCH = KW / 8;
  constexpr int NKC = 64 * KCH;
  bf16* Ks = (bf16*)smem;
  bf16* Vs = Ks + 2 * 64 * KROW;
  const int tid = get_tid(), lane = tid & 63, wave = tid >> 6;
  const int r = lane & 31, h = lane >> 5;
  const int pr = (r & ~12) | ((r & 4) << 1) | ((r & 8) >> 1);
  bf16x8 qfA[NS], qfB[NS];
  {
    const bf16* qa = a.QaA + (size_t)(wave * 32 + r) * a.qsa + 8 * h;
    const bf16* qb = a.QaB + (size_t)(wave * 32 + r) * a.qsa + 8 * h;
#pragma unroll
    for (int s = 0; s < NS; ++s) { qfA[s] = *(const bf16x8*)(qa + s * 16); qfB[s] = *(const bf16x8*)(qb + s * 16); }
  }
#pragma unroll
  for (int e = 0; e < 16; ++e) { oA0[e] = 0.f; oA1[e] = 0.f; oB0[e] = 0.f; oB1[e] = 0.f; }
  float mA = -1e30f, lA = 0.f, mB = -1e30f, lB = 0.f;
  u32x4 rk0 = {0u, 0u, 0u, 0u}, rk1 = rk0, rv0 = rk0;
  const int nt = a.nkeys >> 6;
  const int krow0 = tid / KCH, kch0 = tid % KCH, krow1 = (tid + 512) / KCH, kch1 = (tid + 512) % KCH;
  const int vrow0 = tid >> 3, vch = tid & 7;
  const bool k1on = (NKC > 512) && (tid + 512 < NKC);
  auto gload = [&](int kt) {
    const int key0 = kt << 6;
    const bf16* kb; int ks;
    if (key0 < a.nsplit) { kb = a.Ka + (size_t)key0 * a.ksa; ks = a.ksa; } else { kb = a.Kb + (size_t)(key0 - a.nsplit) * a.ksb; ks = a.ksb; }
    gld16(rk0, kb + (size_t)krow0 * ks + kch0 * 8);
    if (k1on) gld16(rk1, kb + (size_t)krow1 * ks + kch1 * 8);
    gld16(rv0, a.Vt + (size_t)vrow0 * a.vs + key0 + vch * 8);
  };
  auto sstore = [&](int buf) {
    *(u32x4*)(Ks + (buf * 64 + krow0) * KROW + kch0 * 8) = rk0;
    if (k1on) *(u32x4*)(Ks + (buf * 64 + krow1) * KROW + kch1 * 8) = rk1;
    *(u32x4*)(Vs + (buf * 64 + vrow0) * 72 + vch * 8) = rv0;
  };
  __syncthreads();
  gload(0);
  asm volatile("s_waitcnt vmcnt(0)" : "+v"(rk0), "+v"(rk1), "+v"(rv0) : : "memory");
  sstore(0);
  constexpr bool T14 = KSPLIT;
  if (T14 && nt > 1) gload(1);
  __syncthreads();
  for (int kt = 0; kt < nt; ++kt) {
    const int buf = kt & 1;
    if constexpr (T14) {
      if (kt + 1 < nt) {
        asm volatile("s_waitcnt vmcnt(0)" : "+v"(rk0), "+v"(rk1), "+v"(rv0) : : "memory");
        sstore(buf ^ 1);
        if (kt + 2 < nt) gload(kt + 2);
      }
    } else {
      gload(kt + 1 < nt ? kt + 1 : kt);
    }
    if ((kt << 6) == a.nsplit) {
      const bf16* qa = a.QbA + (size_t)(wave * 32 + r) * a.qsb + 8 * h;
      const bf16* qb = a.QbB + (size_t)(wave * 32 + r) * a.qsb + 8 * h;
#pragma unroll
      for (int s = 0; s < NS; ++s) { qfA[s] = *(const bf16x8*)(qa + s * 16); qfB[s] = *(const bf16x8*)(qb + s * 16); }
    }
    f32x16 sA0, sA1, sB0, sB1;
#pragma unroll
    for (int e = 0; e < 16; ++e) { sA0[e] = 0.f; sA1[e] = 0.f; sB0[e] = 0.f; sB1[e] = 0.f; }
    const bf16* kp = Ks + (buf * 64 + pr) * KROW + 8 * h;
#pragma unroll
    for (int s = 0; s < NS; ++s) {
      bf16x8 k0 = *(const bf16x8*)(kp + s * 16), k1 = *(const bf16x8*)(kp + 32 * KROW + s * 16);
      sA0 = MFMA32(k0, qfA[s], sA0);
      sA1 = MFMA32(k1, qfA[s], sA1);
      if constexpr (KSPLIT) { k0 = *(const bf16x8*)(kp + DQK + s * 16); k1 = *(const bf16x8*)(kp + 32 * KROW + DQK + s * 16); }
      sB0 = MFMA32(k0, qfB[s], sB0);
      sB1 = MFMA32(k1, qfB[s], sB1);
    }
    const bf16* vp = Vs + (buf * 64 + r) * 72 + 8 * h;
    softmax_tile(sA0, sA1, mA, lA, oA0, oA1, a.c);
    pv_tile(sA0, sA1, vp, oA0, oA1);
    softmax_tile(sB0, sB1, mB, lB, oB0, oB1, a.c);
    pv_tile(sB0, sB1, vp, oB0, oB1);
    if constexpr (!T14) {
      asm volatile("s_waitcnt vmcnt(0)" : "+v"(rk0), "+v"(rk1), "+v"(rv0) : : "memory");
      sstore(buf ^ 1);
    }
    __syncthreads();
  }
  {
    const float invA = 1.f / (lA + __shfl_xor(lA, 32, 64)), invB = 1.f / (lB + __shfl_xor(lB, 32, 64));
#pragma unroll
    for (int e = 0; e < 16; ++e) { oA0[e] *= invA; oA1[e] *= invA; oB0[e] *= invB; oB1[e] *= invB; }
  }
}

template <int DQK>
DI void attn_kv2(const AttnArgs& a, char* smem, f32x16& o0, f32x16& o1) {
  constexpr int NS = DQK / 16;
  constexpr int KROW = DQK + 8;
  constexpr int KCH = DQK / 8;
  constexpr int NKC = 64 * KCH;
  constexpr int TILE_E = 64 * KROW + 64 * 72;
  bf16* T = (bf16*)smem;
  const int tid = get_tid(), lane = tid & 63, wave = tid >> 6;
  const int g = wave >> 2, qw = wave & 3;
  const int r = lane & 31, h = lane >> 5;
  const int pr = (r & ~12) | ((r & 4) << 1) | ((r & 8) >> 1);
  bf16x8 qf[NS];
  {
    const bf16* qp = a.Qa + (size_t)(qw * 32 + r) * a.qsa + 8 * h;
#pragma unroll
    for (int s = 0; s < NS; ++s) qf[s] = *(const bf16x8*)(qp + s * 16);
  }
#pragma unroll
  for (int e = 0; e < 16; ++e) { o0[e] = 0.f; o1[e] = 0.f; }
  float mrun = -1e30f, lrun = 0.f;
  u32x4 ka0 = {0u, 0u, 0u, 0u}, ka1 = ka0, va0 = ka0, kb0 = ka0, kb1 = ka0, vb0 = ka0;
  const int npair = a.nkeys >> 7, tsw = a.nsplit >> 6;
  const int krow0 = tid / KCH, kch0 = tid % KCH, krow1 = (tid + 512) / KCH, kch1 = (tid + 512) % KCH;
  const int vrow0 = tid >> 3, vch = tid & 7;
  const bool k0on = tid < NKC, k1on = (NKC > 512) && (tid + 512 < NKC);
  auto gload = [&](int j) {
    const int keyA = j << 7, keyB = keyA + 64;
    const bf16* kbA; int ksA; const bf16* kbB; int ksB;
    if (keyA < a.nsplit) { kbA = a.Ka + (size_t)keyA * a.ksa; ksA = a.ksa; } else { kbA = a.Kb + (size_t)(keyA - a.nsplit) * a.ksb; ksA = a.ksb; }
    if (keyB < a.nsplit) { kbB = a.Ka + (size_t)keyB * a.ksa; ksB = a.ksa; } else { kbB = a.Kb + (size_t)(keyB - a.nsplit) * a.ksb; ksB = a.ksb; }
    if (k0on) { gld16(ka0, kbA + (size_t)krow0 * ksA + kch0 * 8); gld16(kb0, kbB + (size_t)krow0 * ksB + kch0 * 8); }
    if (k1on) { gld16(ka1, kbA + (size_t)krow1 * ksA + kch1 * 8); gld16(kb1, kbB + (size_t)krow1 * ksB + kch1 * 8); }
    gld16(va0, a.Vt + (size_t)vrow0 * a.vs + keyA + vch * 8);
    gld16(vb0, a.Vt + (size_t)vrow0 * a.vs + keyB + vch * 8);
  };
  auto sstore = [&](int buf) {
    bf16* sa = T + (buf * 2) * TILE_E; bf16* sb = sa + TILE_E;
    if (k0on) { *(u32x4*)(sa + krow0 * KROW + kch0 * 8) = ka0; *(u32x4*)(sb + krow0 * KROW + kch0 * 8) = kb0; }
    if (k1on) { *(u32x4*)(sa + krow1 * KROW + kch1 * 8) = ka1; *(u32x4*)(sb + krow1 * KROW + kch1 * 8) = kb1; }
    *(u32x4*)(sa + 64 * KROW + vrow0 * 72 + vch * 8) = va0;
    *(u32x4*)(sb + 64 * KROW + vrow0 * 72 + vch * 8) = vb0;
  };
  __syncthreads();
  gload(0);
  asm volatile("s_waitcnt vmcnt(0)" : "+v"(ka0), "+v"(ka1), "+v"(va0), "+v"(kb0), "+v"(kb1), "+v"(vb0) : : "memory");
  sstore(0);
  if (npair > 1) gload(1);
  __syncthreads();
  for (int j = 0; j < npair; ++j) {
    const int buf = j & 1;
    if (j + 1 < npair) {
      asm volatile("s_waitcnt vmcnt(0)" : "+v"(ka0), "+v"(ka1), "+v"(va0), "+v"(kb0), "+v"(kb1), "+v"(vb0) : : "memory");
      sstore(buf ^ 1);
      if (j + 2 < npair) gload(j + 2);
    }
    if (2 * j == tsw) {
      const bf16* qp = a.Qb + (size_t)(qw * 32 + r) * a.qsb + 8 * h;
#pragma unroll
      for (int s = 0; s < NS; ++s) qf[s] = *(const bf16x8*)(qp + s * 16);
    }
    const bf16* slot = T + (buf * 2 + g) * TILE_E;
    f32x16 s0, s1;
#pragma unroll
    for (int e = 0; e < 16; ++e) { s0[e] = 0.f; s1[e] = 0.f; }
    const bf16* kp = slot + pr * KROW + 8 * h;
#pragma unroll
    for (int s = 0; s < NS; ++s) {
      bf16x8 k0 = *(const bf16x8*)(kp + s * 16), k1 = *(const bf16x8*)(kp + 32 * KROW + s * 16);
      s0 = MFMA32(k0, qf[s], s0);
      s1 = MFMA32(k1, qf[s], s1);
    }
    const bf16* vp = slot + 64 * KROW + r * 72 + 8 * h;
    softmax_tile(s0, s1, mrun, lrun, o0, o1, a.c);
    pv_tile(s0, s1, vp, o0, o1);
    __syncthreads();
  }
  const float lsum = lrun + __shfl_xor(lrun, 32, 64);
  float* mg = (float*)smem + (qw * 34) * 64 + lane;
  if (g == 1) {
#pragma unroll
    for (int e = 0; e < 16; ++e) { mg[e * 64] = o0[e]; mg[(16 + e) * 64] = o1[e]; }
    mg[32 * 64] = mrun; mg[33 * 64] = lsum;
  }
  __syncthreads();
  if (g == 0) {
    const float mB = mg[32 * 64], lB = mg[33 * 64];
    const float M = fmaxf(mrun, mB);
    const float fa = __builtin_amdgcn_exp2f(mrun - M), fb = __builtin_amdgcn_exp2f(mB - M);
    const float inv = 1.f / (lsum * fa + lB * fb);
#pragma unroll
    for (int e = 0; e < 16; ++e) {
      o0[e] = (o0[e] * fa + mg[e * 64] * fb) * inv;
      o1[e] = (o1[e] * fa + mg[(16 + e) * 64] * fb) * inv;
    }
  }
}

DI void write_o(bf16* dst, const f32x16& o0, const f32x16& o1, int h) {
#pragma unroll
  for (int g = 0; g < 4; ++g) {
    st4bf(dst + 8 * g + 4 * h, o0[4 * g], o0[4 * g + 1], o0[4 * g + 2], o0[4 * g + 3]);
    st4bf(dst + 32 + 8 * g + 4 * h, o1[4 * g], o1[4 * g + 1], o1[4 * g + 2], o1[4 * g + 3]);
  }
}

DI void convT_units(const float* __restrict__ src, int ldsrc, int srccol0, bf16* __restrict__ dst, int K, int N, int dstrow0, int unit) {
  const int n = unit % N, kc = unit / N;
  const float* s = src + (size_t)(kc * 8) * ldsrc + srccol0 + n;
  float v[8];
#pragma unroll
  for (int j = 0; j < 8; ++j) v[j] = s[(size_t)j * ldsrc];
  uint4 u; u.x = pack2(v[0], v[1]); u.y = pack2(v[2], v[3]); u.z = pack2(v[4], v[5]); u.w = pack2(v[6], v[7]);
  *(uint4*)(dst + (size_t)(dstrow0 + n) * K + kc * 8) = u;
}

DI int seg_src(int n) {
  if (n < 512) return n;
  if (n < 704) return 1024 + (n - 512);
  if (n < 832) return 1216 + (n - 704);
  if (n < 864) return 1344 + (n - 832);
  if (n < 1120) return 1376 + (n - 864);
  if (n < 1248) return 1632 + (n - 1120);
  if (n < 1280) return -1;
  if (n < 1536) return 512 + (n - 1280);
  return 1760 + (n - 1536);
}

DI void phase0(const Params& p, char* smem) {
  const int tid = get_tid();
  float* tab = (float*)smem;
  float* sil = tab + 4096;
  float* red = sil + 3072;
  for (int i = tid; i < 4096; i += NT) tab[i] = cospif((float)i * (1.0f / 2048.0f));
  for (int i = tid; i < 1024; i += NT) {
    float a = p.in[9][i], b = p.in[8][i], c = p.in[8][1024 + i];
    sil[i] = a / (1.f + __expf(-a)); sil[1024 + i] = b / (1.f + __expf(-b)); sil[2048 + i] = c / (1.f + __expf(-c));
  }
  __syncthreads();
  float* mods = (float*)(p.ws + OFF_MODS);
  constexpr int N_MODS = 192, N_MISC = 1;
  constexpr int U_WIN = 1792 * 128;
  constexpr int U_WPQ = 512 * 128;
  constexpr int U_WOUT = 1024 * 128, U_WUQ = 384 * 24, U_WUKV = 512 * 16;
  constexpr int I_WIN = 2 * U_WIN / NT, I_WPQ = 2 * U_WPQ / NT, I_WOUT = 2 * U_WOUT / NT, I_WUQ = 2 * U_WUQ / NT, I_WUKV = 2 * U_WUKV / NT;
  constexpr int I_DFTL = 0, I_DFTC = 256 * 64 / NT;
  constexpr int B0 = N_MODS, B1 = B0 + N_MISC, B2 = B1 + I_WIN, B3 = B2 + I_WPQ, B4 = B3 + I_WOUT, B5 = B4 + I_WUQ, B6 = B5 + I_WUKV, B7 = B6 + I_DFTL, B8 = B7 + I_DFTC;
  for (int it = blockIdx.x; it < B8; it += gridDim.x) {
    if (it < B0) {
      const int l = it / 96, cg = it % 96, j = tid & 63, kq = tid >> 6;
      const float* w = p.in[12] + ((size_t)l * 1024 + kq * 128) * 6144 + cg * 64 + j;
      float a0 = 0.f, a1 = 0.f, a2 = 0.f;
#pragma unroll 8
      for (int k = 0; k < 128; ++k) { const float wv = w[(size_t)k * 6144]; const int kk = kq * 128 + k; a0 += sil[kk] * wv; a1 += sil[1024 + kk] * wv; a2 += sil[2048 + kk] * wv; }
      red[(kq * 3 + 0) * 64 + j] = a0; red[(kq * 3 + 1) * 64 + j] = a1; red[(kq * 3 + 2) * 64 + j] = a2;
      __syncthreads();
      if (tid < 192) {
        const int w3 = tid >> 6, jj = tid & 63, col = cg * 64 + jj;
        float sum = 0.f;
#pragma unroll
        for (int q = 0; q < 8; ++q) sum += red[(q * 3 + w3) * 64 + jj];
        mods[(size_t)(l * 3 + w3) * 6144 + col] = sum + p.in[13][l * 6144 + col];
      }
      __syncthreads();
    } else if (it < B1) {
      float* lam = (float*)(p.ws + OFF_LAM);
      if (tid < 2) {
        const float* lp = p.in[15] + tid * 128;
        float d1 = 0.f, d2 = 0.f;
        for (int i = 0; i < 32; ++i) { d1 += lp[i] * lp[32 + i]; d2 += lp[64 + i] * lp[96 + i]; }
        const float li = 0.8f - 0.6f * expf(-0.3f * (float)tid);
        lam[tid * 2] = expf(d1) - expf(d2) + li;
        lam[tid * 2 + 1] = li;
      }
      float* t32 = (float*)(p.ws + OFF_TAB32);
      float* t64 = (float*)(p.ws + OFF_TAB64);
      for (int i = tid; i < 512; i += NT) {
        const int pos = i >> 3, pp = i & 7;
        const float inv = exp2f(-(float)pp * (13.287712379549449f / 8.f));
        const float ap = (float)pos * inv * 0.3183098861837907f;
        t32[i * 2] = cospif(ap); t32[i * 2 + 1] = sinpif(ap);
      }
      for (int i = tid; i < 1024; i += NT) {
        const int pos = i >> 4, pp = i & 15;
        const float inv = exp2f(-(float)pp * (13.287712379549449f / 16.f));
        const float ap = (float)pos * inv * 0.3183098861837907f;
        t64[i * 2] = cospif(ap); t64[i * 2 + 1] = sinpif(ap);
      }
    } else if (it < B2) {
      int u = (it - B1) * NT + tid;
      const int l = u / U_WIN; u -= l * U_WIN;
      const int n1 = u % 1792, kc = u / 1792;
      const int n = n1 < 1664 ? n1 : 2176 + (n1 - 1664);
      bf16* dst = (bf16*)(p.ws + OFF_WIN) + (size_t)l * 2304 * 1024;
      const int sc = n1 < 1664 ? seg_src(n) : -1;
      uint4 uu = {0u, 0u, 0u, 0u};
      if (sc >= 0) {
        const float* s = p.in[14] + (size_t)l * 1024 * 1888 + (size_t)(kc * 8) * 1888 + sc;
        float v[8];
#pragma unroll
        for (int j = 0; j < 8; ++j) v[j] = s[(size_t)j * 1888];
        uu.x = pack2(v[0], v[1]); uu.y = pack2(v[2], v[3]); uu.z = pack2(v[4], v[5]); uu.w = pack2(v[6], v[7]);
      }
      *(uint4*)(dst + (size_t)n * 1024 + kc * 8) = uu;
    } else if (it < B3) {
      const int q = it - B2, l = q >> 7, kc = q & 127;
      float* src = red + 1536;
      __syncthreads();
      {
        const int j = tid >> 6, c4 = (tid & 63) * 4;
        *(float4*)(src + j * 256 + c4) = *(const float4*)(p.in[14] + (size_t)l * 1024 * 1888 + (size_t)(kc * 8 + j) * 1888 + 768 + c4);
      }
      __syncthreads();
      const int nn = tid, isq = nn >> 8, g = (nn >> 6) & 3, m = nn & 63;
      float v[8] = {0.f, 0.f, 0.f, 0.f, 0.f, 0.f, 0.f, 0.f};
#pragma unroll 4
      for (int c = 0; c < 64; ++c) {
        const int idx = ((m * c) & 63) * 64 + (isq ? 3072 : 0);
        const float tw = tab[idx & 4095];
#pragma unroll
        for (int j = 0; j < 8; ++j) v[j] += src[j * 256 + g * 64 + c] * tw;
      }
      uint4 uu; uu.x = pack2(v[0], v[1]); uu.y = pack2(v[2], v[3]); uu.z = pack2(v[4], v[5]); uu.w = pack2(v[6], v[7]);
      bf16* dst = (bf16*)(p.ws + OFF_WIN) + (size_t)l * 2304 * 1024;
      *(uint4*)(dst + (size_t)(1664 + nn) * 1024 + kc * 8) = uu;
    } else if (it < B4) {
      int u = (it - B3) * NT + tid; const int l = u / U_WOUT; u -= l * U_WOUT;
      convT_units(p.in[23] + (size_t)l * 1024 * 1024, 1024, 0, (bf16*)(p.ws + OFF_WOUT) + (size_t)l * 1024 * 1024, 1024, 1024, 0, u);
    } else if (it < B5) {
      int u = (it - B4) * NT + tid; const int l = u / U_WUQ; u -= l * U_WUQ;
      convT_units(p.in[18] + (size_t)l * 192 * 384, 384, 0, (bf16*)(p.ws + OFF_WUQ) + (size_t)l * 384 * 192, 192, 384, 0, u);
    } else if (it < B6) {
      int u = (it - B5) * NT + tid; const int l = u / U_WUKV; u -= l * U_WUKV;
      convT_units(p.in[20] + (size_t)l * 128 * 512, 512, 0, (bf16*)(p.ws + OFF_WUKV) + (size_t)l * 512 * 128, 128, 512, 0, u);
    } else {
      const int u = (it - B7) * NT + tid;
      const int k = u >> 6, c0 = (u & 63) * 8;
      float v[8];
#pragma unroll
      for (int j = 0; j < 8; ++j) { const int col = c0 + j; const int s = col & 255; const int idx = (16 * ((k * s) & 255) + (col >= 256 ? 1024 : 0)) & 4095; v[j] = tab[idx] * (1.f / 128.f); }
      uint4 uu; uu.x = pack2(v[0], v[1]); uu.y = pack2(v[2], v[3]); uu.z = pack2(v[4], v[5]); uu.w = pack2(v[6], v[7]);
      *(uint4*)((bf16*)(p.ws + OFF_DFTC) + (size_t)k * 512 + c0) = uu;
    }
  }
}

constexpr int NRW = 4;
DI void modnorm_rows(const Params& p, int l, int item, const float* gvec, int ish, int isc) {
  const int tid_ = get_tid(); const int lane = tid_ & 63, wave = tid_ >> 6;
  const int t0 = item * (8 * NRW) + wave * NRW;
  float4 v[NRW][4];
  float ss[NRW];
  if (ish == 0 && l == 0) {
#pragma unroll
    for (int q = 0; q < NRW; ++q) {
      const float* x = xrow(p, 0, t0 + q);
#pragma unroll
      for (int i = 0; i < 4; ++i) v[q][i] = *(const float4*)(x + lane * 4 + 256 * i);
    }
  } else {
#pragma unroll
    for (int q = 0; q < NRW; ++q) {
      const bf16* x = (const bf16*)(p.ws + OFF_XRES) + (size_t)(t0 + q) * 1024;
#pragma unroll
      for (int i = 0; i < 4; ++i) {
        const uint2 u = *(const uint2*)(x + lane * 4 + 256 * i);
        v[q][i].x = __uint_as_float(u.x << 16); v[q][i].y = __uint_as_float(u.x & 0xffff0000u);
        v[q][i].z = __uint_as_float(u.y << 16); v[q][i].w = __uint_as_float(u.y & 0xffff0000u);
      }
    }
  }
#pragma unroll
  for (int q = 0; q < NRW; ++q) {
    ss[q] = 0.f;
#pragma unroll
    for (int i = 0; i < 4; ++i) ss[q] += v[q][i].x * v[q][i].x + v[q][i].y * v[q][i].y + v[q][i].z * v[q][i].z + v[q][i].w * v[q][i].w;
  }
  const int w = whichmod(t0);
  const float* sh = modp(p, l, w, ish);
  const float* sc = modp(p, l, w, isc);
  float4 gm[4], sf[4];
#pragma unroll
  for (int i = 0; i < 4; ++i) {
    const int n = lane * 4 + 256 * i;
    const float4 g = *(const float4*)(gvec + n), s1 = *(const float4*)(sc + n);
    sf[i] = *(const float4*)(sh + n);
    gm[i].x = g.x * (1.f + s1.x); gm[i].y = g.y * (1.f + s1.y); gm[i].z = g.z * (1.f + s1.z); gm[i].w = g.w * (1.f + s1.w);
  }
#pragma unroll
  for (int q = 0; q < NRW; ++q) ss[q] = wsum(ss[q]);
  bf16* hb = (bf16*)(p.ws + OFF_HBUF) + (size_t)t0 * 1024;
#pragma unroll
  for (int q = 0; q < NRW; ++q) {
    const float r = rsqrtf(ss[q] * (1.f / 1024.f) + 1e-6f);
#pragma unroll
    for (int i = 0; i < 4; ++i) {
      const int n = lane * 4 + 256 * i;
      st4bf(hb + (size_t)q * 1024 + n, v[q][i].x * r * gm[i].x + sf[i].x, v[q][i].y * r * gm[i].y + sf[i].y, v[q][i].z * r * gm[i].z + sf[i].z, v[q][i].w * r * gm[i].w + sf[i].w);
    }
  }
}

DI void phaseA(const Params& p, int l) {
  const int tid = get_tid();
  constexpr int I_ROWS = 2048 / NRW;
  constexpr int U_W1 = 4096 * 128, U_W2 = 1024 * 512;
  constexpr int I_W1 = 0, I_W2 = 0;
  constexpr int I_KDC = 32768 / NT, I_KGC = 16384 / NT, I_VTD = 32768 / NT, I_VTG = 16384 / NT, I_CKV = 16384 / NT, I_KR = 32768 / NT;
  constexpr int B0 = I_ROWS, B1 = B0 + I_W1, B2 = B1 + I_W2, B3 = B2 + I_KDC, B4 = B3 + I_KGC, B5 = B4 + I_VTD, B6 = B5 + I_VTG, B7 = B6 + I_CKV, B8 = B7 + I_KR;
  for (int it = blockIdx.x; it < B8; it += gridDim.x) {
    if (it < B0) {
      modnorm_rows(p, l, it, p.in[10] + l * 1024, 0, 1);
    } else if (it < B2) {
    } else if (it < B3) {
      const int u = (it - B2) * NT + tid;
      const int e0 = u * 8, b = e0 >> 17, rem = e0 & 131071;
      const float* s = p.in[2] + ((size_t)(b * 2 + l) * 512) * 256 + rem;
      const float4 x0 = *(const float4*)s, x1 = *(const float4*)(s + 4);
      uint4 uu; uu.x = pack2(x0.x, x0.y); uu.y = pack2(x0.z, x0.w); uu.z = pack2(x1.x, x1.y); uu.w = pack2(x1.z, x1.w);
      *(uint4*)((bf16*)(p.ws + OFF_KDC) + e0) = uu;
    } else if (it < B4) {
      const int u = (it - B3) * NT + tid;
      const int e0 = u * 8, b = e0 >> 16, rem = e0 & 65535;
      const float* s = p.in[6] + ((size_t)(b * 2 + l) * 512) * 128 + rem;
      const float4 x0 = *(const float4*)s, x1 = *(const float4*)(s + 4);
      uint4 uu; uu.x = pack2(x0.x, x0.y); uu.y = pack2(x0.z, x0.w); uu.z = pack2(x1.x, x1.y); uu.w = pack2(x1.z, x1.w);
      *(uint4*)((bf16*)(p.ws + OFF_KGC) + e0) = uu;
    } else if (it < B5) {
      const int u = (it - B4) * NT + tid;
      const int c = u & 255, jc = (u >> 8) & 63, b = u >> 14;
      const float* s = p.in[3] + ((size_t)(b * 2 + l) * 512 + jc * 8) * 256 + c;
      float v[8];
#pragma unroll
      for (int j = 0; j < 8; ++j) v[j] = s[j * 256];
      uint4 uu; uu.x = pack2(v[0], v[1]); uu.y = pack2(v[2], v[3]); uu.z = pack2(v[4], v[5]); uu.w = pack2(v[6], v[7]);
      *(uint4*)((bf16*)(p.ws + OFF_VTDL) + ((size_t)(b * 256 + c)) * 4608 + 4096 + jc * 8) = uu;
    } else if (it < B6) {
      const int u = (it - B5) * NT + tid;
      const int c = u & 127, jc = (u >> 7) & 63, b = u >> 13;
      const float* s = p.in[7] + ((size_t)(b * 2 + l) * 512 + jc * 8) * 128 + c;
      float v[8];
#pragma unroll
      for (int j = 0; j < 8; ++j) v[j] = s[j * 128];
      uint4 uu; uu.x = pack2(v[0], v[1]); uu.y = pack2(v[2], v[3]); uu.z = pack2(v[4], v[5]); uu.w = pack2(v[6], v[7]);
      *(uint4*)((bf16*)(p.ws + OFF_VTGL) + ((size_t)(b * 128 + c)) * 4608 + 4096 + jc * 8) = uu;
    } else if (it < B7) {
      const int u = (it - B6) * NT + tid;
      const int e0 = u * 8, b = e0 >> 16, rem = e0 & 65535, j = rem >> 7, e = rem & 127;
      const float* s = p.in[4] + ((size_t)(b * 2 + l) * 512) * 128 + rem;
      const float4 x0 = *(const float4*)s, x1 = *(const float4*)(s + 4);
      uint4 uu; uu.x = pack2(x0.x, x0.y); uu.y = pack2(x0.z, x0.w); uu.z = pack2(x1.x, x1.y); uu.w = pack2(x1.z, x1.w);
      *(uint4*)((bf16*)(p.ws + OFF_Z) + (size_t)(16384 + b * 512 + j) * ZLD + 704 + e) = uu;
    } else {
      const int u = (it - B7) * NT + tid;
      const int e = u & 31, j = (u >> 5) & 511, b = u >> 14;
      const bf16 v = f2bf(p.in[5][((size_t)(b * 2 + l) * 512 + j) * 32 + e]);
      bf16* km = (bf16*)(p.ws + OFF_KM) + (size_t)(16384 + b * 512 + j) * 384 + 64 + e;
      km[0] = v; km[96] = v; km[192] = v; km[288] = v;
    }
  }
}

DI void dft_lat_item(const Params& p, char* smem, int item, bool& tab_ready) {
  const int tid = get_tid();
  float* tab = (float*)smem;
  if (!tab_ready) {
    __syncthreads();
    for (int i = tid; i < 4096; i += NT) tab[i] = cospif((float)i * (1.0f / 2048.0f));
    __syncthreads();
    tab_ready = true;
  }
  for (int q = 0; q < 16; ++q) {
    const int u = (item * 16 + q) * NT + tid;
    const int k = u >> 10, c0 = (u & 1023) * 8;
    float v[8];
#pragma unroll
    for (int j = 0; j < 8; ++j) { const int col = c0 + j; const int s = col & 4095; const int idx = (k * s + (col >= 4096 ? 1024 : 0)) & 4095; v[j] = tab[idx] * (1.f / 512.f); }
    uint4 uu; uu.x = pack2(v[0], v[1]); uu.y = pack2(v[2], v[3]); uu.z = pack2(v[4], v[5]); uu.w = pack2(v[6], v[7]);
    *(uint4*)((bf16*)(p.ws + OFF_DFTL) + (size_t)k * 8192 + c0) = uu;
  }
}

DI void phaseB(const Params& p, int l, char* smem) {
  const bf16* A = (const bf16*)(p.ws + OFF_HBUF);
  const bf16* Bt = (const bf16*)(p.ws + OFF_WIN) + (size_t)l * 2304 * 1024;
  bf16* Z = (bf16*)(p.ws + OFF_Z);
  float* out = p.out;
  pg8::gemm_phase<true>((LAS unsigned char*)smem, A, Bt, 16384, 2048, 1024,
    [&](const pg8::f32x4 (&acc)[2][2][4][2], const pg8::Unit& u, int wr, int wc, int fr, int fq) {
      const int row0 = u.pm * 256 + wr * 64 + fr;
      const bool ctx = u.pm < 32;
#pragma unroll
      for (int bj = 0; bj < 2; ++bj) {
        const int c0 = u.pn * 256 + bj * 128 + wc * 32 + 8 * fq;
        if (c0 >= 2176) continue;
#pragma unroll
        for (int ai = 0; ai < 2; ++ai)
#pragma unroll
          for (int m = 0; m < 4; ++m) {
            const int row = row0 + ai * 128 + m * 16;
            const pg8::f32x4 v0 = acc[ai][bj][m][0], v1 = acc[ai][bj][m][1];
            if (c0 < 1280) {
              u32x4 w; w.x = pack2(v0[0], v0[1]); w.y = pack2(v0[2], v0[3]); w.z = pack2(v1[0], v1[1]); w.w = pack2(v1[2], v1[3]);
              *(u32x4*)(Z + (size_t)row * ZLD + c0) = w;
            } else {
              const int b = ctx ? (row >> 8) : ((row - 8192) >> 12);
              const int s = ctx ? (row & 255) : ((row - 8192) & 4095);
              const float vv[8] = {v0[0], v0[1], v0[2], v0[3], v1[0], v1[1], v1[2], v1[3]};
              bf16* dst; size_t cs;
              if (c0 < 1536) {
                const int c = c0 - 1280;
                if (ctx) { dst = (bf16*)(p.ws + OFF_VTDC) + (size_t)(b * 256 + c) * 256 + s; cs = 256;
                           float* o = out + O_DV + ((size_t)(b * 2 + l) * 256 + s) * 256 + c; *(pg8::f32x4*)o = v0; *(pg8::f32x4*)(o + 4) = v1; }
                else { dst = (bf16*)(p.ws + OFF_VTDL) + (size_t)(b * 256 + c) * 4608 + s; cs = 4608; }
              } else if (c0 < 1664) {
                const int c = c0 - 1536;
                if (ctx) { dst = (bf16*)(p.ws + OFF_VTGC) + (size_t)(b * 128 + c) * 256 + s; cs = 256;
                           float* o = out + O_GV + ((size_t)(b * 2 + l) * 256 + s) * 128 + c; *(pg8::f32x4*)o = v0; *(pg8::f32x4*)(o + 4) = v1; }
                else { dst = (bf16*)(p.ws + OFF_VTGL) + (size_t)(b * 128 + c) * 4608 + s; cs = 4608; }
              } else {
                const int c = c0 - 1664, isq = c >> 8, ch = c & 255;
                if (ctx) { dst = (bf16*)(p.ws + OFF_PQTC) + (size_t)(b * 256 + ch) * 512 + isq * 256 + s; cs = 512; }
                else { dst = (bf16*)(p.ws + OFF_PQTL) + (size_t)(b * 256 + ch) * 8192 + isq * 4096 + s; cs = 8192; }
              }
#pragma unroll
              for (int j = 0; j < 8; ++j) dst[(size_t)j * cs] = f2bf(vv[j]);
            }
          }
      }
    });
}

DI void wave_lds_fence() { asm volatile("s_waitcnt lgkmcnt(0)" ::: "memory"); }

DI float rope_elem(const float* x, int i, int a  , const float* tab, int prow, int pcol) {
  const int half = i / a, idx = i % a, hp = a >> 1, pp = idx % hp, second = idx / hp;
  const int pos = half ? pcol : prow;
  const float c = tab[(pos * hp + pp) * 2], s = tab[(pos * hp + pp) * 2 + 1];
  const float x1 = x[half * a + pp], x2 = x[half * a + hp + pp];
  return second ? (x1 * s + x2 * c) : (x1 * c - x2 * s);
}

DI void phaseC(const Params& p, int l, char* smem) {
  __syncthreads();
  const int tid = get_tid(), lane = tid & 63, wave = tid >> 6;
  float* xs = (float*)smem + wave * 1280;
  bf16* Z = (bf16*)(p.ws + OFF_Z);
  bf16* QR = (bf16*)(p.ws + OFF_QROT);
  bf16* KM = (bf16*)(p.ws + OFF_KM);
  float* t32 = (float*)smem + 8 * 1280;
  float* t64 = t32 + 1024;
  for (int i = tid; i < 1024; i += NT) t32[i] = ((const float*)(p.ws + OFF_TAB32))[i];
  for (int i = tid; i < 2048; i += NT) t64[i] = ((const float*)(p.ws + OFF_TAB64))[i];
  const float gq0 = p.in[17][l * 192 + lane], gq1 = p.in[17][l * 192 + 64 + lane], gq2 = p.in[17][l * 192 + 128 + lane];
  const float gkv0 = p.in[19][l * 128 + lane], gkv1 = p.in[19][l * 128 + 64 + lane];
  const float ggq0 = p.in[21][l * 64 + lane], ggk0 = p.in[22][l * 64 + lane];
  __syncthreads();
  float* out = p.out;
  uint4 n0 = {0u, 0u, 0u, 0u}, n1 = n0, n2 = n0;
  if (blockIdx.x < 2048) {
    const bf16* zf = Z + (size_t)(blockIdx.x * 8 + wave) * ZLD;
    n0 = *(const uint4*)(zf + lane * 8); n1 = *(const uint4*)(zf + (lane + 64) * 8);
    if (lane < 28) n2 = *(const uint4*)(zf + (lane + 128) * 8);
  }
  for (int it = blockIdx.x; it < 2048; it += gridDim.x) {
    const int t = it * 8 + wave;
    const bool ctx = t < 8192;
    const int b = ctx ? (t >> 8) : ((t - 8192) >> 12);
    const int s = ctx ? (t & 255) : ((t - 8192) & 4095);
    const int tl = t - 8192;
    const int prow = s >> 6, pcol = s & 63;
    bf16* z = Z + (size_t)t * ZLD;
    wave_lds_fence();
    {
      const uint4 uu[3] = {n0, n1, n2};
#pragma unroll
      for (int q = 0; q < 3; ++q) {
        if (q < 2 || lane < 28) {
          const uint4 u = uu[q];
          float* d = xs + (lane + 64 * q) * 8;
          d[0] = __uint_as_float(u.x << 16); d[1] = __uint_as_float(u.x & 0xffff0000u);
          d[2] = __uint_as_float(u.y << 16); d[3] = __uint_as_float(u.y & 0xffff0000u);
          d[4] = __uint_as_float(u.z << 16); d[5] = __uint_as_float(u.z & 0xffff0000u);
          d[6] = __uint_as_float(u.w << 16); d[7] = __uint_as_float(u.w & 0xffff0000u);
        }
      }
    }
    if (it + (int)gridDim.x < 2048) {
      const bf16* zf = Z + (size_t)((it + gridDim.x) * 8 + wave) * ZLD;
      n0 = *(const uint4*)(zf + lane * 8); n1 = *(const uint4*)(zf + (lane + 64) * 8);
      if (lane < 28) n2 = *(const uint4*)(zf + (lane + 128) * 8);
    }
    wave_lds_fence();
    const size_t srow = (size_t)(b * 2 + l) * 256 + s;
#pragma unroll
    for (int j = 0; j < 4; ++j) {
      const int e = lane + 64 * j, m = e >> 5, i = e & 31;
      if (ctx) {
        out[O_DK + srow * 256 + e] = xs[256 + e];
      } else {
        QR[(size_t)tl * 512 + e] = f2bf(rope_elem(xs + m * 32, i, 16, t32, prow, pcol));
        z[256 + e] = f2bf(rope_elem(xs + 256 + m * 32, i, 16, t32, prow, pcol));
      }
    }
    {
      float v0 = xs[512 + lane], v1 = xs[576 + lane], v2 = xs[640 + lane];
      const float ss = wsum(v0 * v0 + v1 * v1 + v2 * v2);
      const float rstd = rsqrtf(ss * (1.f / 192.f) + 1e-6f);
      z[512 + lane] = f2bf(v0 * rstd * gq0); z[576 + lane] = f2bf(v1 * rstd * gq1); z[640 + lane] = f2bf(v2 * rstd * gq2);
    }
    {
      float v0 = xs[704 + lane], v1 = xs[768 + lane];
      const float ss = wsum(v0 * v0 + v1 * v1);
      const float rstd = rsqrtf(ss * (1.f / 128.f) + 1e-6f);
      v0 = v0 * rstd * gkv0; v1 = v1 * rstd * gkv1;
      z[704 + lane] = f2bf(v0); z[768 + lane] = f2bf(v1);
      if (ctx) { out[O_CKV + srow * 128 + lane] = v0; out[O_CKV + srow * 128 + 64 + lane] = v1; }
    }
    {
      const int e = lane & 31, hh = (lane >> 5) * 2;
      float v;
      if (ctx) { v = xs[832 + e]; if (lane < 32) out[O_KR + srow * 32 + e] = v; }
      else v = rope_elem(xs + 832, e, 16, t32, prow, pcol);
      const bf16 bv = f2bf(v);
      KM[(size_t)t * 384 + hh * 96 + 64 + e] = bv;
      KM[(size_t)t * 384 + (hh + 1) * 96 + 64 + e] = bv;
    }
    float nq[4], nk[2];
#pragma unroll
    for (int hh = 0; hh < 4; ++hh) {
      const float v = xs[864 + hh * 64 + lane];
      const float ss = wsum(v * v);
      nq[hh] = v * rsqrtf(ss * (1.f / 64.f) + 1e-6f) * ggq0;
    }
#pragma unroll
    for (int hh = 0; hh < 2; ++hh) {
      const float v = xs[1120 + hh * 64 + lane];
      const float ss = wsum(v * v);
      nk[hh] = v * rsqrtf(ss * (1.f / 64.f) + 1e-6f) * ggk0;
    }
    wave_lds_fence();
#pragma unroll
    for (int hh = 0; hh < 4; ++hh) xs[864 + hh * 64 + lane] = nq[hh];
#pragma unroll
    for (int hh = 0; hh < 2; ++hh) xs[1120 + hh * 64 + lane] = nk[hh];
    wave_lds_fence();
#pragma unroll
    for (int hh = 0; hh < 4; ++hh) {
      z[864 + hh * 64 + lane] = f2bf(nq[hh]);
      if (!ctx) QR[(size_t)tl * 512 + 256 + hh * 64 + lane] = f2bf(rope_elem(xs + 864 + hh * 64, lane, 32, t64, prow, pcol));
    }
#pragma unroll
    for (int hh = 0; hh < 2; ++hh) {
      if (ctx) { z[1120 + hh * 64 + lane] = f2bf(nk[hh]); out[O_GK + srow * 128 + hh * 64 + lane] = nk[hh]; }
      else z[1120 + hh * 64 + lane] = f2bf(rope_elem(xs + 1120 + hh * 64, lane, 32, t64, prow, pcol));
    }
  }
}

DI void phaseD(const Params& p, int l, char* smem) {
  const bf16* Z = (const bf16*)(p.ws + OFF_Z);
  const bf16* Wuq = (const bf16*)(p.ws + OFF_WUQ) + (size_t)l * 384 * 192;
  const bf16* Wukv = (const bf16*)(p.ws + OFF_WUKV) + (size_t)l * 512 * 128;
  bf16* QMP = (bf16*)(p.ws + OFF_QMP); bf16* QMR = (bf16*)(p.ws + OFF_QMR);
  bf16* KM = (bf16*)(p.ws + OFF_KM);
  bf16* vtmc = (bf16*)(p.ws + OFF_VTMC); bf16* vtml = (bf16*)(p.ws + OFF_VTML);
  const float* t32 = (const float*)(p.ws + OFF_TAB32);
  constexpr int N0 = 128, N1 = 64 * 3, N2 = 68 * 4;
  const int NDFT = (l == 0) ? 256 : 0;
  const int tid = get_tid();
  int* ctr = (int*)(p.ws + OFF_CTR) + 4 + l;
  int* sitem = (int*)(smem + 131072);
  bool tab_ready = false;
  for (;;) {
    __syncthreads();
    if (tid == 0) *sitem = atomicAdd(ctr, 1);
    __syncthreads();
    int it = __builtin_amdgcn_readfirstlane(*sitem);
    if (it >= N0 + NDFT + N1 + N2) break;
    if (it < N0) {
      const int mt = it >> 1, nh = it & 1;
      gemm_tile_n64((const bf16*)(p.ws + OFF_HBUF), 1024, (const bf16*)(p.ws + OFF_WIN) + ((size_t)l * 2304 + 2048) * 1024, 1024, 1024, mt * 256, nh * 64, smem,
                [&](int m, int n, float v0, float v1, float v2, float v3) {
                  const bool ctx = m < 8192;
                  const int b = ctx ? (m >> 8) : ((m - 8192) >> 12);
                  const int s = ctx ? (m & 255) : ((m - 8192) & 4095);
                  const int ch = 128 + n;
                  if (ctx) st4bf((bf16*)(p.ws + OFF_PQTC) + (size_t)(b * 256 + ch) * 512 + 256 + s, v0, v1, v2, v3);
                  else st4bf((bf16*)(p.ws + OFF_PQTL) + (size_t)(b * 256 + ch) * 8192 + 4096 + s, v0, v1, v2, v3);
                });
      tab_ready = false;
      continue;
    }
    it -= N0;
    if (it < NDFT) { dft_lat_item(p, smem, it, tab_ready); continue; }
    it -= NDFT;
    tab_ready = false;
    if (it < N1) {
      const int mt = it / 3, nt = it % 3;
      gemm_tile(Z + 512, ZLD, Wuq, 192, 192, mt * 256, nt * 128, smem, [&](int m, int n, float v0, float v1, float v2, float v3) {
        bf16* q = QMP + (size_t)m * 384 + n;
        q[0] = f2bf(v0); q[384] = f2bf(v1); q[768] = f2bf(v2); q[1152] = f2bf(v3);
        const float p0 = __shfl_xor(v0, 8, 64), p1 = __shfl_xor(v1, 8, 64), p2 = __shfl_xor(v2, 8, 64), p3 = __shfl_xor(v3, 8, 64);
        if (m >= 8192) {
          const int w = n % 96;
          float r0 = v0, r1 = v1, r2 = v2, r3 = v3;
          if (w >= 64) {
            const int i = w - 64, half = i >> 4, pp = i & 7, second = (i >> 3) & 1;
            float vv[4] = {v0, v1, v2, v3}, pv[4] = {p0, p1, p2, p3}, rr[4];
#pragma unroll
            for (int ii = 0; ii < 4; ++ii) {
              const int s = (m + ii - 8192) & 4095;
              const int pos = half ? (s & 63) : (s >> 6);
              const float c = t32[(pos * 8 + pp) * 2], sn = t32[(pos * 8 + pp) * 2 + 1];
              rr[ii] = second ? (pv[ii] * sn + vv[ii] * c) : (vv[ii] * c - pv[ii] * sn);
            }
            r0 = rr[0]; r1 = rr[1]; r2 = rr[2]; r3 = rr[3];
          }
          bf16* qr = QMR + (size_t)(m - 8192) * 384 + n;
          qr[0] = f2bf(r0); qr[384] = f2bf(r1); qr[768] = f2bf(r2); qr[1152] = f2bf(r3);
        }
      });
    } else {
      const int i2 = it - N1, mt = i2 >> 2, nt = i2 & 3;
      gemm_tile(Z + 704, ZLD, Wukv, 128, 128, mt * 256, nt * 128, smem, [&](int m, int n, float v0, float v1, float v2, float v3) {
        const int hd = n >> 7, w = n & 127;
        if (w < 64) {
          bf16* k = KM + (size_t)m * 384 + hd * 96 + w;
          k[0] = f2bf(v0); k[384] = f2bf(v1); k[768] = f2bf(v2); k[1152] = f2bf(v3);
        } else {
          const int dv = w - 64;
          if (m < 8192) {
            const int b = m >> 8, key = m & 255;
            st4bf(vtmc + ((size_t)((b * 4 + hd) * 64 + dv)) * 256 + key, v0, v1, v2, v3);
          } else {
            int b, key;
            if (m < 16384) { b = (m - 8192) >> 12; key = (m - 8192) & 4095; } else { b = (m - 16384) >> 9; key = 4096 + ((m - 16384) & 511); }
            st4bf(vtml + ((size_t)((b * 4 + hd) * 64 + dv)) * 4608 + key, v0, v1, v2, v3);
          }
        }
      });
    }
  }
}

DI void phaseE(const Params& p, int l, char* smem) {
  const int tid = get_tid(), lane = tid & 63, wave = tid >> 6, r = lane & 31, h = lane >> 5;
  int* ctr = (int*)(p.ws + OFF_CTR) + l;
  int* sitem = (int*)(smem + 131072);
  bf16* Z = (bf16*)(p.ws + OFF_Z);
  bf16* QR = (bf16*)(p.ws + OFF_QROT);
  bf16* QMP = (bf16*)(p.ws + OFF_QMP); bf16* QMR = (bf16*)(p.ws + OFF_QMR);
  bf16* KM = (bf16*)(p.ws + OFF_KM);
  bf16* ymix = (bf16*)(p.ws + OFF_HBUF);
  constexpr float LOG2E = 1.4426950408889634f;
  constexpr int N_ATT = 1024, I_W1 = 4096 * 128 / NT, I_W2 = 1024 * 512 / NT;
  constexpr int NITEMS = N_ATT + I_W1 + I_W2;
  for (;;) {
    __syncthreads();
    if (tid == 0) *sitem = atomicAdd(ctr, 1);
    __syncthreads();
    const int it = __builtin_amdgcn_readfirstlane(*sitem);
    if (it >= NITEMS) break;
    if (it >= N_ATT) {
      if (it < N_ATT + I_W1) convT_units(p.in[24] + (size_t)l * 1024 * 4096, 4096, 0, (bf16*)(p.ws + OFF_W1), 1024, 4096, 0, (it - N_ATT) * NT + tid);
      else convT_units(p.in[25] + (size_t)l * 4096 * 1024, 1024, 0, (bf16*)(p.ws + OFF_W2), 4096, 1024, 0, (it - N_ATT - I_W1) * NT + tid);
    } else if (it >= 64 && it < 96) {
      const int q = it - 64, b = q >> 4, mt = (q >> 1) & 7, nt = q & 1;
      bf16* yb = ymix + (size_t)(8192 + b * 4096) * 1024 + 256;
      gemm_tile_dual((const bf16*)(p.ws + OFF_DFTL), 8192, (const bf16*)(p.ws + OFF_PQTL) + (size_t)b * 256 * 8192, 8192, 8192, mt * 256, nt * 128, smem,
                     [&](int m, int n, float c, float sn) {
                       yb[(size_t)m * 1024 + n] = f2bf(c + sn);
                       if (m > 0) yb[(size_t)(4096 - m) * 1024 + n] = f2bf(c - sn);
                     });
    } else if (it >= 96 && it < 128) {
      const int t2 = get_tid();
      const int wave2 = t2 >> 6, lane2 = t2 & 63;
      const int q = (it - 96) * 8 + wave2, b = q >> 7, ch0 = (q & 127) * 2;
#pragma unroll
      for (int cc = 0; cc < 2; ++cc) {
        const int ch = ch0 + cc;
        const bf16* pr = (const bf16*)(p.ws + OFF_PQTL) + (size_t)(b * 256 + ch) * 8192;
        float acc = 0.f;
#pragma unroll
        for (int i = 0; i < 8; ++i) {
          const uint4 u = *(const uint4*)(pr + (i * 64 + lane2) * 8);
          acc += __uint_as_float(u.x << 16) - __uint_as_float(u.x & 0xffff0000u) + __uint_as_float(u.y << 16) - __uint_as_float(u.y & 0xffff0000u)
               + __uint_as_float(u.z << 16) - __uint_as_float(u.z & 0xffff0000u) + __uint_as_float(u.w << 16) - __uint_as_float(u.w & 0xffff0000u);
        }
        acc = wsum(acc);
        if (lane2 == 0) ymix[(size_t)(8192 + b * 4096 + 2048) * 1024 + 256 + ch] = f2bf(acc * (1.f / 512.f));
      }
    } else if (it >= 960) {
      const int idx = it - 960, b = idx >> 1, nt = idx & 1;
      gemm_tile((const bf16*)(p.ws + OFF_DFTC), 512, (const bf16*)(p.ws + OFF_PQTC) + (size_t)b * 256 * 512, 512, 512, 0, nt * 128, smem,
                [&](int m, int n, float v0, float v1, float v2, float v3) {
                  bf16* y = ymix + (size_t)(b * 256 + m) * 1024 + 256 + n;
                  y[0] = f2bf(v0); y[1024] = f2bf(v1); y[2048] = f2bf(v2); y[3072] = f2bf(v3);
                });
    } else if ((it >= 256 && it < 512) || (it >= 640 && it < 896)) {
      const bool lat = it < 512;
      const int q = lat ? (it - 256) : (it - 640);
      int b, hd, qb;
      if (lat) { b = q >> 7; hd = (q >> 5) & 3; qb = q & 31; } else { b = q >> 3; hd = (q >> 1) & 3; qb = q & 1; }
      const int tb = lat ? (8192 + b * 4096) : (b * 256), t0 = tb + qb * 128, tl0 = t0 - 8192;
      AttnArgs a;
      a.nkeys = lat ? 4608 : 256; a.nsplit = lat ? 4096 : 256; a.vs = a.nkeys; a.c = 0.10206207261596575f * LOG2E;
      a.Vt = (lat ? (const bf16*)(p.ws + OFF_VTML) + (size_t)((b * 4 + hd) * 64) * 4608 : (const bf16*)(p.ws + OFF_VTMC) + (size_t)((b * 4 + hd) * 64) * 256);
      if (lat) { a.Qa = QMR + (size_t)tl0 * 384 + hd * 96; a.Qb = QMP + (size_t)t0 * 384 + hd * 96; }
      else { a.Qa = QMP + (size_t)t0 * 384 + hd * 96; a.Qb = a.Qa; }
      a.qsa = 384; a.qsb = 384;
      a.Ka = KM + (size_t)tb * 384 + hd * 96; a.ksa = 384;
      a.Kb = KM + (size_t)(16384 + b * 512) * 384 + hd * 96; a.ksb = 384;
      f32x16 o0, o1;
      attn_kv2<96>(a, smem, o0, o1);
      if (wave < 4) write_o(ymix + (size_t)(t0 + wave * 32 + r) * 1024 + 512 + hd * 64, o0, o1, h);
    } else {
      AttnArgs2 a;
      f32x16 oA0, oA1, oB0, oB1;
      if (false) {
      } else if (it < 64 || (it >= 896 && it < 960)) {
        const bool lat = it < 64;
        int b, kvh, qb;
        if (lat) { const int q = it; b = q >> 5; kvh = (q >> 4) & 1; qb = q & 15; } else { const int q = it - 896; b = q >> 1; kvh = q & 1; qb = 0; }
        const int tb = lat ? (8192 + b * 4096) : (b * 256), t0 = tb + qb * 256, tl0 = t0 - 8192;
        a.nkeys = lat ? 4608 : 256; a.nsplit = lat ? 4096 : 256; a.vs = a.nkeys; a.c = 0.125f * LOG2E;
        a.Vt = (lat ? (const bf16*)(p.ws + OFF_VTGL) + (size_t)((b * 2 + kvh) * 64) * 4608 : (const bf16*)(p.ws + OFF_VTGC) + (size_t)((b * 2 + kvh) * 64) * 256);
        const int hA = kvh * 2;
        if (lat) { a.QaA = QR + (size_t)tl0 * 512 + 256 + hA * 64; a.qsa = 512; a.QbA = Z + (size_t)t0 * ZLD + 864 + hA * 64; a.qsb = ZLD; }
        else { a.QaA = Z + (size_t)t0 * ZLD + 864 + hA * 64; a.qsa = ZLD; a.QbA = a.QaA; a.qsb = ZLD; }
        a.QaB = a.QaA + 64; a.QbB = a.QbA + 64;
        a.Ka = Z + (size_t)tb * ZLD + 1120 + kvh * 64; a.ksa = ZLD;
        a.Kb = (const bf16*)(p.ws + OFF_KGC) + (size_t)(b * 512) * 128 + kvh * 64; a.ksb = 128;
        attn_dual<64, false>(a, smem, oA0, oA1, oB0, oB1);
        bf16* yd = ymix + (size_t)(t0 + wave * 32 + r) * 1024 + 768 + hA * 64;
        write_o(yd, oA0, oA1, h);
        write_o(yd + 64, oB0, oB1, h);
      } else {
        const bool lat = it < 256;
        int b, hd, qb;
        if (lat) { const int q = it - 128; b = q >> 6; hd = (q >> 4) & 3; qb = q & 15; } else { const int q = it - 512; b = q >> 2; hd = q & 3; qb = 0; }
        const int tb = lat ? (8192 + b * 4096) : (b * 256), t0 = tb + qb * 256, tl0 = t0 - 8192;
        a.nkeys = lat ? 4608 : 256; a.nsplit = lat ? 4096 : 256; a.vs = a.nkeys; a.c = 0.17677669529663687f * LOG2E;
        a.Vt = (lat ? (const bf16*)(p.ws + OFF_VTDL) + (size_t)((b * 4 + hd) * 64) * 4608 : (const bf16*)(p.ws + OFF_VTDC) + (size_t)((b * 4 + hd) * 64) * 256);
        if (lat) { a.QaA = QR + (size_t)tl0 * 512 + hd * 64; a.qsa = 512; a.QbA = Z + (size_t)t0 * ZLD + hd * 64; a.qsb = ZLD; }
        else { a.QaA = Z + (size_t)t0 * ZLD + hd * 64; a.qsa = ZLD; a.QbA = a.QaA; a.qsb = ZLD; }
        a.QaB = a.QaA + 32; a.QbB = a.QbA + 32;
        a.Ka = Z + (size_t)tb * ZLD + 256 + hd * 64; a.ksa = ZLD;
        a.Kb = (const bf16*)(p.ws + OFF_KDC) + (size_t)(b * 512) * 256 + hd * 64; a.ksb = 256;
        attn_dual<32, true>(a, smem, oA0, oA1, oB0, oB1);
        const float lam = ((const float*)(p.ws + OFF_LAM))[l * 2], lam_init = ((const float*)(p.ws + OFF_LAM))[l * 2 + 1];
        const float* subg = p.in[16] + l * 64;
        float ss = 0.f;
#pragma unroll
        for (int e = 0; e < 16; ++e) { oA0[e] -= lam * oB0[e]; oA1[e] -= lam * oB1[e]; ss += oA0[e] * oA0[e] + oA1[e] * oA1[e]; }
        ss += __shfl_xor(ss, 32, 64);
        const float rstd = rsqrtf(ss * (1.f / 64.f) + 1e-6f) * (1.f - lam_init);
#pragma unroll
        for (int e = 0; e < 16; ++e) {
          const int dv = (e & 3) + 8 * (e >> 2) + 4 * h;
          oA0[e] *= rstd * subg[dv]; oA1[e] *= rstd * subg[32 + dv];
        }
        write_o(ymix + (size_t)(t0 + wave * 32 + r) * 1024 + hd * 64, oA0, oA1, h);
      }
    }
  }
}

DI pg8::f32x4 bf4lo(const u32x4& w) { return (pg8::f32x4){__uint_as_float(w.x << 16), __uint_as_float(w.x & 0xffff0000u), __uint_as_float(w.y << 16), __uint_as_float(w.y & 0xffff0000u)}; }
DI pg8::f32x4 bf4hi(const u32x4& w) { return (pg8::f32x4){__uint_as_float(w.z << 16), __uint_as_float(w.z & 0xffff0000u), __uint_as_float(w.w << 16), __uint_as_float(w.w & 0xffff0000u)}; }

DI void phaseF(const Params& p, int l, char* smem) {
  const bf16* A = (const bf16*)(p.ws + OFF_HBUF);
  const bf16* Bt = (const bf16*)(p.ws + OFF_WOUT) + (size_t)l * 1024 * 1024;
  bf16* xres = (bf16*)(p.ws + OFF_XRES);
  pg8::gemm_phase<true>((LAS unsigned char*)smem, A, Bt, 16384, 1024, 1024,
    [&](const pg8::f32x4 (&acc)[2][2][4][2], const pg8::Unit& u, int wr, int wc, int fr, int fq) {
      const int row0 = u.pm * 256 + wr * 64 + fr, col0 = u.pn * 256 + wc * 32 + 8 * fq;
      const float* g1 = modp(p, l, whichmod(u.pm * 256), 2);
      pg8::f32x4 ga[2], gb[2];
#pragma unroll
      for (int bj = 0; bj < 2; ++bj) { ga[bj] = *(const pg8::f32x4*)(g1 + col0 + bj * 128); gb[bj] = *(const pg8::f32x4*)(g1 + col0 + bj * 128 + 4); }
      if (l == 0) {
#pragma unroll
        for (int ai = 0; ai < 2; ++ai)
#pragma unroll
          for (int mh = 0; mh < 2; ++mh) {
            pg8::f32x4 xa[2][2], xb[2][2];
#pragma unroll
            for (int m2 = 0; m2 < 2; ++m2)
#pragma unroll
              for (int bj = 0; bj < 2; ++bj) {
                const float* xr = xrow(p, 0, row0 + ai * 128 + (mh * 2 + m2) * 16) + col0 + bj * 128;
                xa[m2][bj] = *(const pg8::f32x4*)xr; xb[m2][bj] = *(const pg8::f32x4*)(xr + 4);
              }
#pragma unroll
            for (int m2 = 0; m2 < 2; ++m2)
#pragma unroll
              for (int bj = 0; bj < 2; ++bj) {
                const int m = mh * 2 + m2;
                const pg8::f32x4 ya = xa[m2][bj] + ga[bj] * acc[ai][bj][m][0], yb = xb[m2][bj] + gb[bj] * acc[ai][bj][m][1];
                u32x4 o; o.x = pack2(ya[0], ya[1]); o.y = pack2(ya[2], ya[3]); o.z = pack2(yb[0], yb[1]); o.w = pack2(yb[2], yb[3]);
                *(u32x4*)(xres + (size_t)(row0 + ai * 128 + m * 16) * 1024 + col0 + bj * 128) = o;
              }
          }
      } else {
#pragma unroll
        for (int ai = 0; ai < 2; ++ai) {
          u32x4 w[4][2];
#pragma unroll
          for (int m = 0; m < 4; ++m)
#pragma unroll
            for (int bj = 0; bj < 2; ++bj) w[m][bj] = *(const u32x4*)(xres + (size_t)(row0 + ai * 128 + m * 16) * 1024 + col0 + bj * 128);
#pragma unroll
          for (int m = 0; m < 4; ++m)
#pragma unroll
            for (int bj = 0; bj < 2; ++bj) {
              const pg8::f32x4 ya = bf4lo(w[m][bj]) + ga[bj] * acc[ai][bj][m][0], yb = bf4hi(w[m][bj]) + gb[bj] * acc[ai][bj][m][1];
              u32x4 o; o.x = pack2(ya[0], ya[1]); o.y = pack2(ya[2], ya[3]); o.z = pack2(yb[0], yb[1]); o.w = pack2(yb[2], yb[3]);
              *(u32x4*)(xres + (size_t)(row0 + ai * 128 + m * 16) * 1024 + col0 + bj * 128) = o;
            }
        }
      }
    });
}

DI void phaseG(const Params& p, int l) {
  for (int it = blockIdx.x; it < 2048 / NRW; it += gridDim.x) modnorm_rows(p, l, it, p.in[11] + l * 1024, 3, 4);
}

DI void phaseH(const Params& p, char* smem) {
  const bf16* A = (const bf16*)(p.ws + OFF_HBUF);
  const bf16* Bt = (const bf16*)(p.ws + OFF_W1);
  bf16* ab = (bf16*)(p.ws + OFF_A);
  pg8::gemm_phase<true>((LAS unsigned char*)smem, A, Bt, 16384, 4096, 1024,
    [&](const pg8::f32x4 (&acc)[2][2][4][2], const pg8::Unit& u, int wr, int wc, int fr, int fq) {
      const int row0 = u.pm * 256 + wr * 64 + fr, col0 = u.pn * 256 + wc * 32 + 8 * fq;
#pragma unroll
      for (int ai = 0; ai < 2; ++ai)
#pragma unroll
        for (int m = 0; m < 4; ++m) {
          bf16* rowp = ab + (size_t)(row0 + ai * 128 + m * 16) * 4096 + col0;
#pragma unroll
          for (int bj = 0; bj < 2; ++bj) {
            pg8::f32x4 v0 = acc[ai][bj][m][0], v1 = acc[ai][bj][m][1];
#pragma unroll
            for (int j = 0; j < 4; ++j) { v0[j] = fmaxf(v0[j], 0.f); v0[j] *= v0[j]; v1[j] = fmaxf(v1[j], 0.f); v1[j] *= v1[j]; }
            u32x4 w; w.x = pack2(v0[0], v0[1]); w.y = pack2(v0[2], v0[3]); w.z = pack2(v1[0], v1[1]); w.w = pack2(v1[2], v1[3]);
            *(u32x4*)(rowp + bj * 128) = w;
          }
        }
    });
}

DI void phaseI(const Params& p, int l, char* smem) {
  const bf16* A = (const bf16*)(p.ws + OFF_A);
  const bf16* Bt = (const bf16*)(p.ws + OFF_W2);
  bf16* xres = (bf16*)(p.ws + OFF_XRES);
  pg8::gemm_phase<true>((LAS unsigned char*)smem, A, Bt, 16384, 1024, 4096,
    [&](const pg8::f32x4 (&acc)[2][2][4][2], const pg8::Unit& u, int wr, int wc, int fr, int fq) {
      const int row0 = u.pm * 256 + wr * 64 + fr, col0 = u.pn * 256 + wc * 32 + 8 * fq;
      const float* g2 = modp(p, l, whichmod(u.pm * 256), 5);
      pg8::f32x4 ga[2], gb[2];
#pragma unroll
      for (int bj = 0; bj < 2; ++bj) { ga[bj] = *(const pg8::f32x4*)(g2 + col0 + bj * 128); gb[bj] = *(const pg8::f32x4*)(g2 + col0 + bj * 128 + 4); }
#pragma unroll
      for (int ai = 0; ai < 2; ++ai) {
        u32x4 w[4][2];
#pragma unroll
        for (int m = 0; m < 4; ++m)
#pragma unroll
          for (int bj = 0; bj < 2; ++bj) w[m][bj] = *(const u32x4*)(xres + (size_t)(row0 + ai * 128 + m * 16) * 1024 + col0 + bj * 128);
#pragma unroll
        for (int m = 0; m < 4; ++m)
#pragma unroll
          for (int bj = 0; bj < 2; ++bj) {
            const pg8::f32x4 ya = bf4lo(w[m][bj]) + ga[bj] * acc[ai][bj][m][0], yb = bf4hi(w[m][bj]) + gb[bj] * acc[ai][bj][m][1];
            u32x4 o; o.x = pack2(ya[0], ya[1]); o.y = pack2(ya[2], ya[3]); o.z = pack2(yb[0], yb[1]); o.w = pack2(yb[2], yb[3]);
            *(u32x4*)(xres + (size_t)(row0 + ai * 128 + m * 16) * 1024 + col0 + bj * 128) = o;
          }
      }
    });
}

DI void phaseZ(const Params& p) {
  const int tid_ = get_tid(); const int lane = tid_ & 63, wave = tid_ >> 6;
  const float* g = p.in[26];
  float4 gg4[4];
#pragma unroll
  for (int i = 0; i < 4; ++i) gg4[i] = *(const float4*)(g + lane * 4 + 256 * i);
  for (int it = blockIdx.x; it < 1024; it += gridDim.x) {
    const int t0 = it * 16 + wave * 2;
    const bf16* xa = (const bf16*)(p.ws + OFF_XRES) + (size_t)t0 * 1024;
    const bf16* xb = xa + 1024;
    float* ya = p.out + (size_t)t0 * 1024;
    float* yb = ya + 1024;
    float4 va[4], vb[4];
    float sa = 0.f, sb = 0.f;
#pragma unroll
    for (int i = 0; i < 4; ++i) {
      const uint2 ua = *(const uint2*)(xa + lane * 4 + 256 * i), ub = *(const uint2*)(xb + lane * 4 + 256 * i);
      va[i].x = __uint_as_float(ua.x << 16); va[i].y = __uint_as_float(ua.x & 0xffff0000u); va[i].z = __uint_as_float(ua.y << 16); va[i].w = __uint_as_float(ua.y & 0xffff0000u);
      vb[i].x = __uint_as_float(ub.x << 16); vb[i].y = __uint_as_float(ub.x & 0xffff0000u); vb[i].z = __uint_as_float(ub.y << 16); vb[i].w = __uint_as_float(ub.y & 0xffff0000u);
    }
#pragma unroll
    for (int i = 0; i < 4; ++i) {
      sa += va[i].x * va[i].x + va[i].y * va[i].y + va[i].z * va[i].z + va[i].w * va[i].w;
      sb += vb[i].x * vb[i].x + vb[i].y * vb[i].y + vb[i].z * vb[i].z + vb[i].w * vb[i].w;
    }
    sa = wsum(sa); sb = wsum(sb);
    const float ra = rsqrtf(sa * (1.f / 1024.f) + 1e-6f), rb = rsqrtf(sb * (1.f / 1024.f) + 1e-6f);
#pragma unroll
    for (int i = 0; i < 4; ++i) {
      const int n = lane * 4 + 256 * i;
      const float4 gg = gg4[i];
      float4 o; o.x = va[i].x * ra * gg.x; o.y = va[i].y * ra * gg.y; o.z = va[i].z * ra * gg.z; o.w = va[i].w * ra * gg.w;
      *(float4*)(ya + n) = o;
      o.x = vb[i].x * rb * gg.x; o.y = vb[i].y * rb * gg.y; o.z = vb[i].z * rb * gg.z; o.w = vb[i].w * rb * gg.w;
      *(float4*)(yb + n) = o;
    }
  }
}

template <int PH>
DI void run_phase(const Params& p, int l, char* smem) {
  if (PH == 0) phase0(p, smem);
  else if (PH == 1) phaseA(p, l);
  else if (PH == 2) phaseB(p, l, smem);
  else if (PH == 3) phaseC(p, l, smem);
  else if (PH == 4) phaseD(p, l, smem);
  else if (PH == 5) phaseE(p, l, smem);
  else if (PH == 6) phaseF(p, l, smem);
  else if (PH == 7) phaseG(p, l);
  else if (PH == 8) phaseH(p, smem);
  else if (PH == 9) phaseI(p, l, smem);
  else phaseZ(p);
}

typedef const Params __attribute__((address_space(4)))* KArgP;
DI KArgP kargs() { KArgP q = (KArgP)__builtin_amdgcn_kernarg_segment_ptr(); asm volatile("" : "+s"(q)); return q; }
#define RUN(PH, L) do { const Params pl_ = *kargs(); run_phase<PH>(pl_, (L), smem); } while (0)

DI void grid_barrier(char* smem) {
  XcdBarrier b;
  b.bar = (unsigned*)(kargs()->ws + OFF_BAR); b.x = xb_xcc_id(); b.st = (volatile LAS unsigned*)(smem + 131080);
  xcd_barrier(b);
}

__global__ void __launch_bounds__(NT, 2) mega_kernel(Params p) {
#if defined(__HIP_DEVICE_COMPILE__)
  __shared__ __attribute__((aligned(16))) char smem[SMEM_BYTES];
  cg::grid_group grid = cg::this_grid();
  if (threadIdx.x == 0) { *(volatile unsigned*)(smem + 131080) = 0u; *(volatile unsigned*)(smem + 131084) = 0u; }
  __syncthreads();
  (void)xcd_barrier_post((unsigned*)(p.ws + OFF_BAR), (volatile LAS unsigned*)(smem + 131080));
  if (p.ws == nullptr) grid.sync();
  RUN(0, 0); grid_barrier(smem);
  for (int l = 0; l < 2; ++l) {
    RUN(1, l); grid_barrier(smem);
    RUN(2, l); grid_barrier(smem);
    RUN(3, l); grid_barrier(smem);
    RUN(4, l); grid_barrier(smem);
    RUN(5, l); grid_barrier(smem);
    RUN(6, l); grid_barrier(smem);
    RUN(7, l); grid_barrier(smem);
    RUN(8, l); grid_barrier(smem);
    RUN(9, l); grid_barrier(smem);
  }
  RUN(10, 0);
#endif
}

extern "C" void kernel_launch(void* const* d_in, const int* in_sizes, int n_in, void* d_out, int out_size, void* d_ws, size_t ws_size, hipStream_t stream) {
  Params p{};
  for (int i = 0; i < 27; ++i) p.in[i] = (const float*)d_in[i];
  p.out = (float*)d_out;
  p.ws = (char*)d_ws;
  if (ws_size < OFF_END) { fprintf(stderr, "workspace too small: %zu < %zu\n", ws_size, (size_t)OFF_END); return; }
  (void)hipMemsetAsync(d_ws, 0, 16384, stream);
  static int grid_blocks = 0;
  if (!grid_blocks) {
    int dev = 0, cus = 0, per_cu = 0;
    (void)hipGetDevice(&dev);
    (void)hipDeviceGetAttribute(&cus, hipDeviceAttributeMultiprocessorCount, dev);
    (void)hipOccupancyMaxActiveBlocksPerMultiprocessor(&per_cu, mega_kernel, NT, 0);
    if (per_cu > 1) per_cu = 1;
    grid_blocks = cus * per_cu;
  }
  void* args[] = {&p};
  hipError_t e = hipLaunchCooperativeKernel((void*)mega_kernel, dim3(grid_blocks), dim3(NT), args, 0, stream);
  if (e != hipSuccess) fprintf(stderr, "cooperative launch failed: %s (grid %d)\n", hipGetErrorString(e), grid_blocks);
}
```

```cpp
#include <hip/hip_runtime.h>
#include <hip/hip_cooperative_groups.h>
#include <cstdio>
namespace cg = cooperative_groups;


typedef unsigned short bf16;
typedef __attribute__((ext_vector_type(8))) short bf16x8;
typedef __attribute__((ext_vector_type(16))) float f32x16;
typedef __attribute__((ext_vector_type(2))) float f32x2;
typedef __attribute__((ext_vector_type(4))) unsigned u32x4;
typedef __attribute__((ext_vector_type(2))) __bf16 bf2v;
#define DI __device__ __forceinline__
#define MFMA32(a, b, c) __builtin_amdgcn_mfma_f32_32x32x16_bf16((a), (b), (c), 0, 0, 0)

struct Params { const float* in[27]; float* out; char* ws; };

constexpr size_t OFF_CTR = 0;
constexpr size_t OFF_BAR = 256;
constexpr size_t OFF_MODS = 16384;
constexpr size_t OFF_LAM = OFF_MODS + 2ull * 3 * 6144 * 4;
constexpr size_t OFF_TAB32 = OFF_LAM + 256;
constexpr size_t OFF_TAB64 = OFF_TAB32 + 4096;
constexpr size_t OFF_WIN = OFF_TAB64 + 8192;
constexpr size_t OFF_WOUT = OFF_WIN + 2ull * 2304 * 1024 * 2;
constexpr size_t OFF_WUQ = OFF_WOUT + 2ull * 1024 * 1024 * 2;
constexpr size_t OFF_WUKV = OFF_WUQ + 2ull * 384 * 192 * 2;
constexpr size_t OFF_DFTL = OFF_WUKV + 2ull * 512 * 128 * 2;
constexpr size_t OFF_XRES = OFF_DFTL + 2048ull * 8192 * 2;
constexpr size_t OFF_DFTC = OFF_DFTL + 4096ull * 8192 * 2;
constexpr size_t OFF_W1 = OFF_DFTC + 256ull * 512 * 2;
constexpr size_t OFF_W2 = OFF_W1 + 4096ull * 1024 * 2;
constexpr size_t OFF_HBUF = OFF_W2 + 4096ull * 1024 * 2;
constexpr size_t OFF_R = OFF_HBUF + 16384ull * 1024 * 2;
constexpr size_t OFF_A = OFF_R;
constexpr size_t OFF_Z = OFF_R;
constexpr size_t OFF_QROT = OFF_Z + 17408ull * 1280 * 2;
constexpr size_t OFF_QMP = OFF_QROT + 8192ull * 512 * 2;
constexpr size_t OFF_QMR = OFF_QMP + 16384ull * 384 * 2;
constexpr size_t OFF_KM = OFF_QMR + 8192ull * 384 * 2;
constexpr size_t OFF_VTMC = OFF_KM + 17408ull * 384 * 2;
constexpr size_t OFF_VTML = OFF_VTMC + 32ull * 4 * 64 * 256 * 2;
constexpr size_t OFF_VTDC = OFF_VTML + 2ull * 4 * 64 * 4608 * 2;
constexpr size_t OFF_VTDL = OFF_VTDC + 32ull * 4 * 64 * 256 * 2;
constexpr size_t OFF_VTGC = OFF_VTDL + 2ull * 4 * 64 * 4608 * 2;
constexpr size_t OFF_VTGL = OFF_VTGC + 32ull * 2 * 64 * 256 * 2;
constexpr size_t OFF_PQTC = OFF_VTGL + 2ull * 2 * 64 * 4608 * 2;
constexpr size_t OFF_PQTL = OFF_PQTC + 32ull * 256 * 512 * 2;
constexpr size_t OFF_KDC = OFF_PQTL + 2ull * 256 * 8192 * 2;
constexpr size_t OFF_KGC = OFF_KDC + 2ull * 512 * 256 * 2;
constexpr size_t OFF_END_ATT = OFF_KGC + 2ull * 512 * 128 * 2;
constexpr size_t OFF_END_A = OFF_A + 16384ull * 4096 * 2;
constexpr size_t OFF_END = OFF_END_A > OFF_END_ATT ? OFF_END_A : OFF_END_ATT;

constexpr size_t O_DK = 16777216, O_DV = 20971520, O_CKV = 25165824, O_KR = 27262976, O_GK = 27787264, O_GV = 29884416;

constexpr int NT = 512;
constexpr int SMEM_BYTES = 131072 + 16;
constexpr int ZLD = 1280;

DI int get_tid() { int t = threadIdx.x; asm volatile("" : "+v"(t)); return t; }
DI void gld16(u32x4& r, const void* p) { asm volatile("global_load_dwordx4 %0, %1, off" : "=v"(r) : "v"(p) : "memory"); }
DI unsigned pack2(float a, float b) { f32x2 v = {a, b}; bf2v r = __builtin_convertvector(v, bf2v); return __builtin_bit_cast(unsigned, r); }
DI bf16 f2bf(float a) { return (bf16)(pack2(a, 0.f) & 0xffffu); }
DI float bf2f(bf16 b) { return __uint_as_float(((unsigned)b) << 16); }
template <int CTRL> DI float dpp_f(float v) { return __builtin_bit_cast(float, __builtin_amdgcn_update_dpp(0, __builtin_bit_cast(int, v), CTRL, 0xF, 0xF, true)); }
DI float wsum(float v) {
  v += dpp_f<0xB1>(v);
  v += dpp_f<0x4E>(v);
  v += dpp_f<0x141>(v);
  v += dpp_f<0x140>(v);
  const int b = __builtin_bit_cast(int, v);
  const float r0 = __builtin_bit_cast(float, __builtin_amdgcn_readlane(b, 0)), r1 = __builtin_bit_cast(float, __builtin_amdgcn_readlane(b, 16));
  const float r2 = __builtin_bit_cast(float, __builtin_amdgcn_readlane(b, 32)), r3 = __builtin_bit_cast(float, __builtin_amdgcn_readlane(b, 48));
  return (r0 + r1) + (r2 + r3);
}
DI int whichmod(int t) { return t < 8192 ? 0 : 1 + ((t - 8192) >> 12); }
DI const float* xrow(const Params& p, int l, int t) {
  if (l == 0) return t < 8192 ? p.in[0] + (size_t)t * 1024 : p.in[1] + (size_t)(t - 8192) * 1024;
  return p.out + (size_t)t * 1024;
}
DI const float* modp(const Params& p, int l, int w, int i) { return (const float*)(p.ws + OFF_MODS) + ((size_t)(l * 3 + w) * 6 + i) * 1024; }
DI void st4bf(bf16* dst, float a, float b, float c, float d) { uint2 u; u.x = pack2(a, b); u.y = pack2(c, d); *(uint2*)dst = u; }


#define XB_TMO      128
#define XB_XCNT(j)  (256  + 64 * (j))
#define XB_XSUB(j)  (1280 + 64 * (j))
#define XB_XGEN(j)  (2304 + 64 * (j))
#define XB_TOP      3328
#define XB_TOPGEN   3392
#define XB_SPIN_CAP (1u << 22)
#define LAS __attribute__((address_space(3)))
DI unsigned xb_ld(unsigned* p) { return __hip_atomic_load(p, __ATOMIC_RELAXED, __HIP_MEMORY_SCOPE_AGENT); }
DI unsigned xb_add(unsigned* p, unsigned v) { return __hip_atomic_fetch_add(p, v, __ATOMIC_RELAXED, __HIP_MEMORY_SCOPE_AGENT); }
DI unsigned xb_xcc_id() { return (unsigned)__builtin_amdgcn_s_getreg((3 << 11) | 20) & 0xFu; }
#define XB_SPIN(cond, bar) do { unsigned _sp = 0; while (cond) { __builtin_amdgcn_s_sleep(1); \
    if ((++_sp & 255u) == 0u) { if (xb_ld(&(bar)[XB_TMO])) break; if (_sp > XB_SPIN_CAP) { atomicAdd(&(bar)[XB_TMO], 1u); break; } } } } while (0)
struct XcdBarrier { unsigned* bar; unsigned x; volatile LAS unsigned* st; };
DI XcdBarrier xcd_barrier_post(unsigned* bar, volatile LAS unsigned* st) {
  XcdBarrier b; b.bar = bar; b.x = xb_xcc_id(); b.st = st;
  if (threadIdx.x == 0) (void)xb_add(&bar[XB_XCNT(b.x)], 1u);
  return b;
}
DI void xcd_barrier_complete(unsigned* bar, unsigned x, unsigned& nloc, unsigned& nx) {
  const unsigned G = gridDim.x * gridDim.y * gridDim.z;
  unsigned sum, cnt, mine, sp = 0u;
  for (;;) {
    sum = 0u; cnt = 0u; mine = 0u;
#pragma unroll
    for (unsigned j = 0; j < 16; ++j) { const unsigned c = xb_ld(&bar[XB_XCNT(j)]); sum += c; cnt += (c > 0u) ? 1u : 0u; mine = (j == x) ? c : mine; }
    if (sum == G) break;
    __builtin_amdgcn_s_sleep(1);
    if ((++sp & 255u) == 0u) { if (xb_ld(&bar[XB_TMO])) break; if (sp > XB_SPIN_CAP) { atomicAdd(&bar[XB_TMO], 1u); break; } }
  }
  nloc = mine > 0u ? mine : 1u; nx = cnt > 0u ? cnt : 1u;
}
DI void xcd_barrier(const XcdBarrier& b) {
  asm volatile("s_waitcnt vmcnt(0)" ::: "memory");
  __syncthreads();
  if (threadIdx.x == 0) {
    unsigned* bar = b.bar;
    __builtin_amdgcn_s_waitcnt(0);
    unsigned nloc = b.st[0], nx = b.st[1];
    if (nloc == 0u) { xcd_barrier_complete(bar, b.x, nloc, nx); b.st[0] = nloc; b.st[1] = nx; }
    const unsigned old = xb_add(&bar[XB_XSUB(b.x)], 1u);
    const unsigned gen = old / nloc;
    if (old + 1u == (gen + 1u) * nloc) {
      __builtin_amdgcn_fence(__ATOMIC_RELEASE, "agent");
      asm volatile("s_waitcnt vmcnt(0)" ::: "memory");
      const unsigned og = xb_add(&bar[XB_TOP], 1u);
      const unsigned tg = og / nx;
      if (og + 1u == (tg + 1u) * nx) xb_add(&bar[XB_TOPGEN], 1u);
      else XB_SPIN(xb_ld(&bar[XB_TOPGEN]) == tg, bar);
      __builtin_amdgcn_fence(__ATOMIC_ACQUIRE, "agent");
      xb_add(&bar[XB_XGEN(b.x)], 1u);
      asm volatile("s_waitcnt vmcnt(0)" ::: "memory");
    } else {
      XB_SPIN(xb_ld(&bar[XB_XGEN(b.x)]) == gen, bar);
      __builtin_amdgcn_fence(__ATOMIC_ACQUIRE, "agent");
      asm volatile("s_waitcnt vmcnt(0)" ::: "memory");
    }
  }
  __syncthreads();
}

template <class Epi>
DI void gemm_tile(const bf16* __restrict__ A, int lda, const bf16* __restrict__ Bt, int ldb, int K, int m0, int n0, char* smem, Epi epi) {
  bf16* As = (bf16*)smem;
  bf16* Bs = As + 2 * 256 * 72;
  const int tid = get_tid(), lane = tid & 63, wave = tid >> 6;
  const int r = lane & 31, h = lane >> 5, wm = wave >> 1, wn = wave & 1;
  const int lr = tid >> 3, lc = (tid & 7) * 8;
  const bf16* ag = A + (size_t)(m0 + lr) * lda + lc;
  const bf16* bg = Bt + (size_t)(n0 + lr) * ldb + lc;
  f32x16 acc[2][2];
#pragma unroll
  for (int i = 0; i < 2; ++i)
#pragma unroll
    for (int j = 0; j < 2; ++j)
#pragma unroll
      for (int e = 0; e < 16; ++e) acc[i][j][e] = 0.f;
  u32x4 ra0, ra1, ra2, ra3, rb0, rb1;
  const bf16* ag1 = ag + (size_t)64 * lda; const bf16* ag2 = ag + (size_t)128 * lda; const bf16* ag3 = ag + (size_t)192 * lda;
  const bf16* bg1 = bg + (size_t)64 * ldb;
  bf16* asw = As + lr * 72 + lc;
  bf16* bsw = Bs + lr * 72 + lc;
  __syncthreads();
  ra0 = *(const u32x4*)ag; ra1 = *(const u32x4*)ag1; ra2 = *(const u32x4*)ag2; ra3 = *(const u32x4*)ag3;
  rb0 = *(const u32x4*)bg; rb1 = *(const u32x4*)bg1;
  *(u32x4*)(asw) = ra0; *(u32x4*)(asw + 64 * 72) = ra1; *(u32x4*)(asw + 128 * 72) = ra2; *(u32x4*)(asw + 192 * 72) = ra3;
  *(u32x4*)(bsw) = rb0; *(u32x4*)(bsw + 64 * 72) = rb1;
  const int nk = K >> 6;
  if (nk > 1) { gld16(ra0, ag + 64); gld16(rb0, bg + 64); gld16(ra1, ag1 + 64); gld16(rb1, bg1 + 64); gld16(ra2, ag2 + 64); gld16(ra3, ag3 + 64); }
  __syncthreads();
  for (int kt = 0; kt < nk; ++kt) {
    const int buf = kt & 1;
    if (kt + 1 < nk) {
      asm volatile("s_waitcnt vmcnt(0)" : "+v"(ra0), "+v"(ra1), "+v"(ra2), "+v"(ra3), "+v"(rb0), "+v"(rb1) : : "memory");
      const int nba = (buf ^ 1) * 256 * 72, nbb = (buf ^ 1) * 128 * 72;
      *(u32x4*)(asw + nba) = ra0; *(u32x4*)(asw + nba + 64 * 72) = ra1; *(u32x4*)(asw + nba + 128 * 72) = ra2; *(u32x4*)(asw + nba + 192 * 72) = ra3;
      *(u32x4*)(bsw + nbb) = rb0; *(u32x4*)(bsw + nbb + 64 * 72) = rb1;
      if (kt + 2 < nk) {
        const int k0 = (kt + 2) << 6;
        gld16(ra0, ag + k0); gld16(rb0, bg + k0); gld16(ra1, ag1 + k0); gld16(rb1, bg1 + k0); gld16(ra2, ag2 + k0); gld16(ra3, ag3 + k0);
      }
    }
    const bf16* as = As + (buf * 256 + wm * 64 + r) * 72 + 8 * h;
    const bf16* bs = Bs + (buf * 128 + wn * 64 + r) * 72 + 8 * h;
#pragma unroll
    for (int ks = 0; ks < 4; ++ks) {
      bf16x8 a0 = *(const bf16x8*)(as + ks * 16), a1 = *(const bf16x8*)(as + 32 * 72 + ks * 16);
      bf16x8 b0 = *(const bf16x8*)(bs + ks * 16), b1 = *(const bf16x8*)(bs + 32 * 72 + ks * 16);
      acc[0][0] = MFMA32(a0, b0, acc[0][0]);
      acc[0][1] = MFMA32(a0, b1, acc[0][1]);
      acc[1][0] = MFMA32(a1, b0, acc[1][0]);
      acc[1][1] = MFMA32(a1, b1, acc[1][1]);
    }
    __syncthreads();
  }
#pragma unroll
  for (int i = 0; i < 2; ++i)
#pragma unroll
    for (int j = 0; j < 2; ++j)
#pragma unroll
      for (int g = 0; g < 4; ++g) {
        const int m = m0 + wm * 64 + i * 32 + 8 * g + 4 * h;
        const int n = n0 + wn * 64 + j * 32 + r;
        epi(m, n, acc[i][j][4 * g], acc[i][j][4 * g + 1], acc[i][j][4 * g + 2], acc[i][j][4 * g + 3]);
      }
}

template <class Epi>
DI void gemm_tile_n64(const bf16* __restrict__ A, int lda, const bf16* __restrict__ Bt, int ldb, int K, int m0, int n0, char* smem, Epi epi) {
  bf16* As = (bf16*)smem;
  bf16* Bs = As + 2 * 256 * 72;
  const int tid = get_tid(), lane = tid & 63, wave = tid >> 6;
  const int r = lane & 31, h = lane >> 5, wm = wave >> 1, wn = wave & 1;
  const int lr = tid >> 3, lc = (tid & 7) * 8;
  const bf16* ag = A + (size_t)(m0 + lr) * lda + lc;
  const bf16* bg = Bt + (size_t)(n0 + lr) * ldb + lc;
  f32x16 acc[2];
#pragma unroll
  for (int i = 0; i < 2; ++i)
#pragma unroll
    for (int e = 0; e < 16; ++e) acc[i][e] = 0.f;
  u32x4 ra0, ra1, ra2, ra3, rb0;
  const bf16* ag1 = ag + (size_t)64 * lda; const bf16* ag2 = ag + (size_t)128 * lda; const bf16* ag3 = ag + (size_t)192 * lda;
  bf16* asw = As + lr * 72 + lc;
  bf16* bsw = Bs + lr * 72 + lc;
  __syncthreads();
  ra0 = *(const u32x4*)ag; ra1 = *(const u32x4*)ag1; ra2 = *(const u32x4*)ag2; ra3 = *(const u32x4*)ag3; rb0 = *(const u32x4*)bg;
  *(u32x4*)(asw) = ra0; *(u32x4*)(asw + 64 * 72) = ra1; *(u32x4*)(asw + 128 * 72) = ra2; *(u32x4*)(asw + 192 * 72) = ra3; *(u32x4*)(bsw) = rb0;
  const int nk = K >> 6;
  if (nk > 1) { gld16(ra0, ag + 64); gld16(rb0, bg + 64); gld16(ra1, ag1 + 64); gld16(ra2, ag2 + 64); gld16(ra3, ag3 + 64); }
  __syncthreads();
  for (int kt = 0; kt < nk; ++kt) {
    const int buf = kt & 1;
    if (kt + 1 < nk) {
      asm volatile("s_waitcnt vmcnt(0)" : "+v"(ra0), "+v"(ra1), "+v"(ra2), "+v"(ra3), "+v"(rb0) : : "memory");
      const int nba = (buf ^ 1) * 256 * 72, nbb = (buf ^ 1) * 64 * 72;
      *(u32x4*)(asw + nba) = ra0; *(u32x4*)(asw + nba + 64 * 72) = ra1; *(u32x4*)(asw + nba + 128 * 72) = ra2; *(u32x4*)(asw + nba + 192 * 72) = ra3;
      *(u32x4*)(bsw + nbb) = rb0;
      if (kt + 2 < nk) {
        const int k0 = (kt + 2) << 6;
        gld16(ra0, ag + k0); gld16(rb0, bg + k0); gld16(ra1, ag1 + k0); gld16(ra2, ag2 + k0); gld16(ra3, ag3 + k0);
      }
    }
    const bf16* as = As + (buf * 256 + wm * 64 + r) * 72 + 8 * h;
    const bf16* bs = Bs + (buf * 64 + wn * 32 + r) * 72 + 8 * h;
#pragma unroll
    for (int ks = 0; ks < 4; ++ks) {
      bf16x8 a0 = *(const bf16x8*)(as + ks * 16), a1 = *(const bf16x8*)(as + 32 * 72 + ks * 16);
      bf16x8 b0 = *(const bf16x8*)(bs + ks * 16);
      acc[0] = MFMA32(a0, b0, acc[0]);
      acc[1] = MFMA32(a1, b0, acc[1]);
    }
    __syncthreads();
  }
#pragma unroll
  for (int i = 0; i < 2; ++i)
#pragma unroll
    for (int g = 0; g < 4; ++g) {
      const int m = m0 + wm * 64 + i * 32 + 8 * g + 4 * h;
      const int n = n0 + wn * 32 + r;
      epi(m, n, acc[i][4 * g], acc[i][4 * g + 1], acc[i][4 * g + 2], acc[i][4 * g + 3]);
    }
}

template <class Epi>
DI void gemm_tile_dual(const bf16* __restrict__ A, int lda, const bf16* __restrict__ Bt, int ldb, int K, int m0, int n0, char* smem, Epi epi) {
  bf16* As = (bf16*)smem;
  bf16* Bs = As + 2 * 256 * 72;
  const int tid = get_tid(), lane = tid & 63, wave = tid >> 6;
  const int r = lane & 31, h = lane >> 5, wm = wave >> 1, wn = wave & 1;
  const int lr = tid >> 3, lc = (tid & 7) * 8;
  const bf16* ag = A + (size_t)(m0 + lr) * lda + lc;
  const bf16* bg = Bt + (size_t)(n0 + lr) * ldb + lc;
  f32x16 accC[2][2], accS[2][2];
#pragma unroll
  for (int i = 0; i < 2; ++i)
#pragma unroll
    for (int j = 0; j < 2; ++j)
#pragma unroll
      for (int e = 0; e < 16; ++e) { accC[i][j][e] = 0.f; accS[i][j][e] = 0.f; }
  u32x4 ra0, ra1, ra2, ra3, rb0, rb1;
  const bf16* ag1 = ag + (size_t)64 * lda; const bf16* ag2 = ag + (size_t)128 * lda; const bf16* ag3 = ag + (size_t)192 * lda;
  const bf16* bg1 = bg + (size_t)64 * ldb;
  bf16* asw = As + lr * 72 + lc;
  bf16* bsw = Bs + lr * 72 + lc;
  __syncthreads();
  ra0 = *(const u32x4*)ag; ra1 = *(const u32x4*)ag1; ra2 = *(const u32x4*)ag2; ra3 = *(const u32x4*)ag3;
  rb0 = *(const u32x4*)bg; rb1 = *(const u32x4*)bg1;
  *(u32x4*)(asw) = ra0; *(u32x4*)(asw + 64 * 72) = ra1; *(u32x4*)(asw + 128 * 72) = ra2; *(u32x4*)(asw + 192 * 72) = ra3;
  *(u32x4*)(bsw) = rb0; *(u32x4*)(bsw + 64 * 72) = rb1;
  const int nk = K >> 6;
  if (nk > 1) { gld16(ra0, ag + 64); gld16(rb0, bg + 64); gld16(ra1, ag1 + 64); gld16(rb1, bg1 + 64); gld16(ra2, ag2 + 64); gld16(ra3, ag3 + 64); }
  __syncthreads();
  auto step = [&](int kt, f32x16 (&acc)[2][2]) {
    const int buf = kt & 1;
    if (kt + 1 < nk) {
      asm volatile("s_waitcnt vmcnt(0)" : "+v"(ra0), "+v"(ra1), "+v"(ra2), "+v"(ra3), "+v"(rb0), "+v"(rb1) : : "memory");
      const int nba = (buf ^ 1) * 256 * 72, nbb = (buf ^ 1) * 128 * 72;
      *(u32x4*)(asw + nba) = ra0; *(u32x4*)(asw + nba + 64 * 72) = ra1; *(u32x4*)(asw + nba + 128 * 72) = ra2; *(u32x4*)(asw + nba + 192 * 72) = ra3;
      *(u32x4*)(bsw + nbb) = rb0; *(u32x4*)(bsw + nbb + 64 * 72) = rb1;
      if (kt + 2 < nk) {
        const int k0 = (kt + 2) << 6;
        gld16(ra0, ag + k0); gld16(rb0, bg + k0); gld16(ra1, ag1 + k0); gld16(rb1, bg1 + k0); gld16(ra2, ag2 + k0); gld16(ra3, ag3 + k0);
      }
    }
    const bf16* as = As + (buf * 256 + wm * 64 + r) * 72 + 8 * h;
    const bf16* bs = Bs + (buf * 128 + wn * 64 + r) * 72 + 8 * h;
#pragma unroll
    for (int ks = 0; ks < 4; ++ks) {
      bf16x8 a0 = *(const bf16x8*)(as + ks * 16), a1 = *(const bf16x8*)(as + 32 * 72 + ks * 16);
      bf16x8 b0 = *(const bf16x8*)(bs + ks * 16), b1 = *(const bf16x8*)(bs + 32 * 72 + ks * 16);
      acc[0][0] = MFMA32(a0, b0, acc[0][0]);
      acc[0][1] = MFMA32(a0, b1, acc[0][1]);
      acc[1][0] = MFMA32(a1, b0, acc[1][0]);
      acc[1][1] = MFMA32(a1, b1, acc[1][1]);
    }
    __syncthreads();
  };
  for (int kt = 0; kt < (nk >> 1); ++kt) step(kt, accC);
  for (int kt = (nk >> 1); kt < nk; ++kt) step(kt, accS);
#pragma unroll
  for (int i = 0; i < 2; ++i)
#pragma unroll
    for (int j = 0; j < 2; ++j)
#pragma unroll
      for (int g = 0; g < 4; ++g) {
        const int m = m0 + wm * 64 + i * 32 + 8 * g + 4 * h;
        const int n = n0 + wn * 64 + j * 32 + r;
#pragma unroll
        for (int q = 0; q < 4; ++q) epi(m + q, n, accC[i][j][4 * g + q], accS[i][j][4 * g + q]);
      }
}

namespace pg8 {
typedef float f32x4 __attribute__((ext_vector_type(4)));
constexpr int BM = 256, BK = 64, HALF = 128, HTB = HALF * BK * 2, NXCD = 8, WGM = 8;
DI int lds_byte(int r, int c) { const int st = (r >> 4) * 2 + (c >> 5), rr = r & 15, cc = c & 31, ob = rr * 64 + cc * 2; return st * 1024 + (ob ^ (((ob >> 9) & 1) << 5)); }
DI void stage_rc(int b, int& R, int& C) { const int st = b / 1024, sb = b % 1024, swz = sb ^ (((sb >> 9) & 1) << 5); R = (st >> 1) * 16 + swz / 64; C = (st & 1) * 32 + (swz % 64) / 2; }
DI int perm32(int rho) { const int n = rho >> 4, i = rho & 15; return 8 * (i >> 2) + 4 * n + (i & 3); }
struct Unit { int pm, pn; };
struct StaticOrder {
  int nM, nN, nwg, G, c;
  DI void init(int M, int N, int G_, int c_) { nM = M / BM; nN = N / BM; nwg = nM * nN; G = G_; c = c_; }
  DI bool next(int i, Unit& u) const {
    const long L = (long)i * G + c; if (L >= nwg) return false;
    int wgid = (int)L; { const int q = nwg / NXCD, r = nwg % NXCD, xcd = wgid % NXCD, off = wgid / NXCD; wgid = (xcd < r ? xcd * (q + 1) : r * (q + 1) + (xcd - r) * q) + off; }
    const int nig = WGM * nN, gid = wgid / nig, fm = gid * WGM, gsz = (nM - fm) < WGM ? (nM - fm) : WGM;
    u.pm = fm + ((wgid % nig) % gsz); u.pn = (wgid % nig) / gsz; return true;
  }
};
template <bool PERM, class Epi>
DI void gemm_phase(LAS unsigned char* lds, const bf16* gA, const bf16* gBt, int M, int N, int K, const Epi& E) {
  const int tid = get_tid(), wid = __builtin_amdgcn_readfirstlane(tid >> 6), lane = tid & 63, wr = wid >> 2, wc = wid & 3, fr = lane & 15, fq = lane >> 4;
  const int nt = K / BK;
  StaticOrder S; S.init(M, N, gridDim.x, blockIdx.x);
  unsigned voffA[2], voffB[2];
#pragma unroll
  for (int i = 0; i < 2; ++i) { int R, C; stage_rc(tid * 16 + i * 8192, R, C); const int Rb = PERM ? ((R & ~31) + perm32(R & 31)) : R;
    voffA[i] = (unsigned)(R * K + C) * 2u; voffB[i] = (unsigned)(Rb * K + C) * 2u; }
  const size_t kstep = (size_t)(BK * 2);
  const size_t hstep = (size_t)HALF * K * 2;
  const size_t tstep = 2 * hstep;
  const unsigned ldsw = (unsigned)wid * 1024u;
  const int aoff = lds_byte(wr * 64 + fr, fq * 8), boff = lds_byte(wc * 32 + fr, fq * 8);
#define PG8_SA(b, h) (((b) * 2 + (h)) * HTB)
#define PG8_SB(b, h) ((4 + (b) * 2 + (h)) * HTB)
#define PG8_STAGE(bufoff, gbase, voff) do { _Pragma("unroll") for (int _i = 0; _i < 2; ++_i) \
    __builtin_amdgcn_global_load_lds((const unsigned*)((const char*)(gbase) + (voff)[_i]), (LAS unsigned*)(lds + (bufoff) + ldsw + _i * 8192), 16, 0, 0); } while (0)
#define PG8_LDA(dst, b, h) do { _Pragma("unroll") for (int m = 0; m < 4; ++m) _Pragma("unroll") for (int k = 0; k < 2; ++k) dst[m][k] = *(const LAS bf16x8*)(lds + PG8_SA(b, h) + aoff + m * 2048 + k * 1024); } while (0)
#define PG8_LDB(dst, b, h) do { _Pragma("unroll") for (int n = 0; n < 2; ++n) _Pragma("unroll") for (int k = 0; k < 2; ++k) dst[n][k] = *(const LAS bf16x8*)(lds + PG8_SB(b, h) + boff + n * 2048 + k * 1024); } while (0)
#define PG8_MMA(ai, bj, At, Bt) do { __builtin_amdgcn_s_setprio(1); _Pragma("unroll") for (int m = 0; m < 4; ++m) _Pragma("unroll") for (int n = 0; n < 2; ++n) _Pragma("unroll") for (int k = 0; k < 2; ++k) \
    acc[ai][bj][m][n] = __builtin_amdgcn_mfma_f32_16x16x32_bf16(Bt[n][k], At[m][k], acc[ai][bj][m][n], 0, 0, 0); __builtin_amdgcn_s_setprio(0); } while (0)
#define PG8_WAIT_V(n) asm volatile("s_waitcnt vmcnt(" #n ")" ::: "memory")
#define PG8_WAIT_L(n) asm volatile("s_waitcnt lgkmcnt(" #n ")" ::: "memory")
#define PG8_BAR __builtin_amdgcn_s_barrier()
#define PG8_SCHED __builtin_amdgcn_sched_barrier(0)
  Unit cur, nxt; int ui = 0;
  if (!S.next(0, cur)) return;
  f32x4 acc[2][2][4][2];
#pragma unroll
  for (int a = 0; a < 2; ++a)
#pragma unroll
    for (int b = 0; b < 2; ++b)
#pragma unroll
      for (int m = 0; m < 4; ++m)
#pragma unroll
        for (int n = 0; n < 2; ++n) acc[a][b][m][n] = (f32x4){0.f, 0.f, 0.f, 0.f};
  bf16x8 At[4][2], B0[2][2], B1[2][2];
  const char* cA = (const char*)gA + (size_t)cur.pm * tstep; const char* cB = (const char*)gBt + (size_t)cur.pn * tstep;
  PG8_STAGE(PG8_SB(0, 0), cB, voffB); PG8_STAGE(PG8_SA(0, 0), cA, voffA); PG8_STAGE(PG8_SB(0, 1), cB + hstep, voffB); PG8_STAGE(PG8_SA(0, 1), cA + hstep, voffA);
  if (wr == 1) PG8_BAR;
  PG8_WAIT_V(4); PG8_BAR;
  PG8_STAGE(PG8_SB(1, 0), cB + kstep, voffB); PG8_STAGE(PG8_SA(1, 0), cA + kstep, voffA); PG8_STAGE(PG8_SB(1, 1), cB + hstep + kstep, voffB);
  PG8_WAIT_V(6); PG8_BAR;
  for (;;) {
    const bool has_next = S.next(ui + 1, nxt);
    const char* nA = has_next ? (const char*)gA + (size_t)nxt.pm * tstep : cA; const char* nB = has_next ? (const char*)gBt + (size_t)nxt.pn * tstep : cB;
    for (int t = 0; t < nt; t += 2) {
      const bool last = (t == nt - 2);
      const char* a1 = cA + (size_t)(t + 1) * kstep;
      const char* a2 = last ? nA : cA + (size_t)(t + 2) * kstep; const char* b2 = last ? nB : cB + (size_t)(t + 2) * kstep;
      const char* a3 = a2 + kstep; const char* b3 = b2 + kstep;
      PG8_LDB(B0, 0, 0); PG8_SCHED; PG8_LDA(At, 0, 0); PG8_STAGE(PG8_SA(1, 1), a1 + hstep, voffA);
      PG8_WAIT_L(8); PG8_BAR; PG8_WAIT_L(0); PG8_MMA(0, 0, At, B0); PG8_BAR; PG8_SCHED;
      PG8_LDB(B1, 0, 1); PG8_STAGE(PG8_SB(0, 0), b2, voffB);
      PG8_BAR; PG8_WAIT_L(0); PG8_MMA(0, 1, At, B1); PG8_BAR;
      PG8_LDA(At, 0, 1); PG8_STAGE(PG8_SA(0, 0), a2, voffA);
      PG8_BAR; PG8_WAIT_L(0); PG8_MMA(1, 0, At, B0); PG8_BAR; PG8_SCHED;
      PG8_STAGE(PG8_SB(0, 1), b2 + hstep, voffB);
      PG8_WAIT_V(6); PG8_BAR; PG8_MMA(1, 1, At, B1); PG8_BAR;
      PG8_LDB(B0, 1, 0); PG8_SCHED; PG8_LDA(At, 1, 0); PG8_STAGE(PG8_SA(0, 1), a2 + hstep, voffA);
      PG8_WAIT_L(8); PG8_BAR; PG8_WAIT_L(0); PG8_MMA(0, 0, At, B0); PG8_BAR; PG8_SCHED;
      PG8_LDB(B1, 1, 1); PG8_STAGE(PG8_SB(1, 0), b3, voffB);
      PG8_BAR; PG8_WAIT_L(0); PG8_MMA(0, 1, At, B1); PG8_BAR;
      PG8_LDA(At, 1, 1); PG8_STAGE(PG8_SA(1, 0), a3, voffA);
      PG8_BAR; PG8_WAIT_L(0); PG8_MMA(1, 0, At, B0); PG8_BAR; PG8_SCHED;
      PG8_STAGE(PG8_SB(1, 1), b3 + hstep, voffB);
      PG8_WAIT_V(6); PG8_BAR; PG8_MMA(1, 1, At, B1); PG8_BAR;
    }
    E(acc, cur, wr, wc, fr, fq);
    if (!has_next) break;
#pragma unroll
    for (int a = 0; a < 2; ++a)
#pragma unroll
      for (int b = 0; b < 2; ++b)
#pragma unroll
        for (int m = 0; m < 4; ++m)
#pragma unroll
          for (int n = 0; n < 2; ++n) acc[a][b][m][n] = (f32x4){0.f, 0.f, 0.f, 0.f};
    cur = nxt; cA = nA; cB = nB; ++ui;
  }
  PG8_WAIT_V(0);
  if (wr == 0) PG8_BAR;
  PG8_BAR;
#undef PG8_SA
#undef PG8_SB
#undef PG8_STAGE
#undef PG8_LDA
#undef PG8_LDB
#undef PG8_MMA
#undef PG8_WAIT_V
#undef PG8_WAIT_L
#undef PG8_BAR
#undef PG8_SCHED
}
}

struct AttnArgs {
  const bf16 *Qa, *Qb, *Ka, *Kb, *Vt;
  int qsa, qsb, ksa, ksb, vs, nkeys, nsplit;
  float c;
};

DI void softmax_tile(f32x16& s0, f32x16& s1, float& mrun, float& lrun, f32x16& o0, f32x16& o1, float c) {
  float mx = s0[0];
#pragma unroll
  for (int e = 1; e < 16; ++e) mx = fmaxf(mx, s0[e]);
#pragma unroll
  for (int e = 0; e < 16; ++e) mx = fmaxf(mx, s1[e]);
  mx = fmaxf(mx, __shfl_xor(mx, 32, 64));
  const float mt = mx * c;
  float mnew = mrun;
  if (__builtin_amdgcn_ballot_w64(mt > mrun + 8.f) != 0ull) {
    mnew = fmaxf(mrun, mt);
    const float alpha = __builtin_amdgcn_exp2f(mrun - mnew);
    const f32x2 aa = {alpha, alpha};
    lrun *= alpha;
#pragma unroll
    for (int e = 0; e < 8; ++e) {
      f32x2 a0 = {o0[2 * e], o0[2 * e + 1]}, a1 = {o1[2 * e], o1[2 * e + 1]};
      a0 *= aa; a1 *= aa;
      o0[2 * e] = a0.x; o0[2 * e + 1] = a0.y; o1[2 * e] = a1.x; o1[2 * e + 1] = a1.y;
    }
    mrun = mnew;
  }
  const f32x2 cc = {c, c}, mm = {-mnew, -mnew};
  f32x2 ps = {0.f, 0.f};
#pragma unroll
  for (int e = 0; e < 8; ++e) {
    f32x2 t = {s0[2 * e], s0[2 * e + 1]};
    t = t * cc + mm;
    t.x = __builtin_amdgcn_exp2f(t.x); t.y = __builtin_amdgcn_exp2f(t.y);
    s0[2 * e] = t.x; s0[2 * e + 1] = t.y;
    ps += t;
  }
#pragma unroll
  for (int e = 0; e < 8; ++e) {
    f32x2 t = {s1[2 * e], s1[2 * e + 1]};
    t = t * cc + mm;
    t.x = __builtin_amdgcn_exp2f(t.x); t.y = __builtin_amdgcn_exp2f(t.y);
    s1[2 * e] = t.x; s1[2 * e + 1] = t.y;
    ps += t;
  }
  lrun += ps.x + ps.y;
}

DI void pv_tile(const f32x16& s0, const f32x16& s1, const bf16* vp, f32x16& o0, f32x16& o1) {
#pragma unroll
  for (int s = 0; s < 2; ++s) {
    uint4 u;
    u.x = pack2(s0[8 * s], s0[8 * s + 1]); u.y = pack2(s0[8 * s + 2], s0[8 * s + 3]);
    u.z = pack2(s0[8 * s + 4], s0[8 * s + 5]); u.w = pack2(s0[8 * s + 6], s0[8 * s + 7]);
    bf16x8 pf = __builtin_bit_cast(bf16x8, u);
    bf16x8 v0 = *(const bf16x8*)(vp + 16 * s), v1 = *(const bf16x8*)(vp + 32 * 72 + 16 * s);
    o0 = MFMA32(v0, pf, o0);
    o1 = MFMA32(v1, pf, o1);
  }
#pragma unroll
  for (int s = 0; s < 2; ++s) {
    uint4 u;
    u.x = pack2(s1[8 * s], s1[8 * s + 1]); u.y = pack2(s1[8 * s + 2], s1[8 * s + 3]);
    u.z = pack2(s1[8 * s + 4], s1[8 * s + 5]); u.w = pack2(s1[8 * s + 6], s1[8 * s + 7]);
    bf16x8 pf = __builtin_bit_cast(bf16x8, u);
    bf16x8 v0 = *(const bf16x8*)(vp + 32 + 16 * s), v1 = *(const bf16x8*)(vp + 32 * 72 + 32 + 16 * s);
    o0 = MFMA32(v0, pf, o0);
    o1 = MFMA32(v1, pf, o1);
  }
}

template <int DQK>
DI void attn_core(const AttnArgs& a, char* smem, f32x16& o0, f32x16& o1) {
  constexpr int NS = DQK / 16;
  constexpr int KROW = DQK + 8;
  constexpr int KCH = DQK / 8;
  bf16* Ks = (bf16*)smem;
  bf16* Vs = Ks + 2 * 64 * KROW;
  const int tid = get_tid(), lane = tid & 63, wave = tid >> 6;
  const int r = lane & 31, h = lane >> 5;
  const int pr = (r & ~12) | ((r & 4) << 1) | ((r & 8) >> 1);
  bf16x8 qf[NS];
  {
    const bf16* qp = a.Qa + (size_t)(wave * 32 + r) * a.qsa + 8 * h;
#pragma unroll
    for (int s = 0; s < NS; ++s) qf[s] = *(const bf16x8*)(qp + s * 16);
  }
#pragma unroll
  for (int e = 0; e < 16; ++e) { o0[e] = 0.f; o1[e] = 0.f; }
  float mrun = -1e30f, lrun = 0.f;
  u32x4 rk0 = {0u, 0u, 0u, 0u}, rk1 = rk0, rv0 = rk0;
  const int nt = a.nkeys >> 6;
  constexpr int NKC = 64 * KCH;
  const int krow0 = tid / KCH, kch0 = tid % KCH, krow1 = (tid + 512) / KCH, kch1 = (tid + 512) % KCH;
  const int vrow0 = tid >> 3, vch = tid & 7;
  const bool k0on = tid < NKC, k1on = (NKC > 512) && (tid + 512 < NKC);
  auto gload = [&](int kt) {
    const int key0 = kt << 6;
    const bf16* kb; int ks;
    if (key0 < a.nsplit) { kb = a.Ka + (size_t)key0 * a.ksa; ks = a.ksa; } else { kb = a.Kb + (size_t)(key0 - a.nsplit) * a.ksb; ks = a.ksb; }
    if (k0on) gld16(rk0, kb + (size_t)krow0 * ks + kch0 * 8);
    if (k1on) gld16(rk1, kb + (size_t)krow1 * ks + kch1 * 8);
    gld16(rv0, a.Vt + (size_t)vrow0 * a.vs + key0 + vch * 8);
  };
  auto sstore = [&](int buf) {
    if (k0on) *(u32x4*)(Ks + (buf * 64 + krow0) * KROW + kch0 * 8) = rk0;
    if (k1on) *(u32x4*)(Ks + (buf * 64 + krow1) * KROW + kch1 * 8) = rk1;
    *(u32x4*)(Vs + (buf * 64 + vrow0) * 72 + vch * 8) = rv0;
  };
  __syncthreads();
  gload(0);
  asm volatile("s_waitcnt vmcnt(0)" : "+v"(rk0), "+v"(rk1), "+v"(rv0) : : "memory");
  sstore(0);
  __syncthreads();
  for (int kt = 0; kt < nt; ++kt) {
    const int buf = kt & 1;
    gload(kt + 1 < nt ? kt + 1 : kt);
    if ((kt << 6) == a.nsplit) {
      const bf16* qp = a.Qb + (size_t)(wave * 32 + r) * a.qsb + 8 * h;
#pragma unroll
      for (int s = 0; s < NS; ++s) qf[s] = *(const bf16x8*)(qp + s * 16);
    }
    f32x16 s0, s1;
#pragma unroll
    for (int e = 0; e < 16; ++e) { s0[e] = 0.f; s1[e] = 0.f; }
    const bf16* kp = Ks + (buf * 64 + pr) * KROW + 8 * h;
#pragma unroll
    for (int s = 0; s < NS; ++s) {
      bf16x8 k0 = *(const bf16x8*)(kp + s * 16), k1 = *(const bf16x8*)(kp + 32 * KROW + s * 16);
      s0 = MFMA32(k0, qf[s], s0);
      s1 = MFMA32(k1, qf[s], s1);
    }
    const bf16* vp = Vs + (buf * 64 + r) * 72 + 8 * h;
    softmax_tile(s0, s1, mrun, lrun, o0, o1, a.c);
    pv_tile(s0, s1, vp, o0, o1);
    asm volatile("s_waitcnt vmcnt(0)" : "+v"(rk0), "+v"(rk1), "+v"(rv0) : : "memory");
    sstore(buf ^ 1);
    __syncthreads();
  }
  const float ltot = lrun + __shfl_xor(lrun, 32, 64);
  const float inv = 1.f / ltot;
#pragma unroll
  for (int e = 0; e < 16; ++e) { o0[e] *= inv; o1[e] *= inv; }
}


struct AttnArgs2 {
  const bf16 *QaA, *QbA, *QaB, *QbB;
  const bf16 *Ka, *Kb, *Vt;
  int qsa, qsb, ksa, ksb, vs, nkeys, nsplit;
  float c;
};

template <int DQK, bool KSPLIT>
DI void attn_dual(const AttnArgs2& a, char* smem, f32x16& oA0, f32x16& oA1, f32x16& oB0, f32x16& oB1) {
  constexpr int NS = DQK / 16;
  constexpr int KW = KSPLIT ? 2 * DQK : DQK;
  constexpr int KROW = KW + 8;
  constexpr int KCH = KW / 8;
  constexpr int NKC = 64 * KCH;
  bf16* Ks = (bf16*)smem;
  bf16* Vs = Ks + 2 * 64 * KROW;
  const int tid = get_tid(), lane = tid & 63, wave = tid >> 6;
  const int r = lane & 31, h = lane >> 5;
  const int pr = (r & ~12) | ((r & 4) << 1) | ((r & 8) >> 1);
  bf16x8 qfA[NS], qfB[NS];
  {
    const bf16* qa = a.QaA + (size_t)(wave * 32 + r) * a.qsa + 8 * h;
    const bf16* qb = a.QaB + (size_t)(wave * 32 + r) * a.qsa + 8 * h;
#pragma unroll
    for (int s = 0; s < NS; ++s) { qfA[s] = *(const bf16x8*)(qa + s * 16); qfB[s] = *(const bf16x8*)(qb + s * 16); }
  }
#pragma unroll
  for (int e = 0; e < 16; ++e) { oA0[e] = 0.f; oA1[e] = 0.f; oB0[e] = 0.f; oB1[e] = 0.f; }
  float mA = -1e30f, lA = 0.f, mB = -1e30f, lB = 0.f;
  u32x4 rk0 = {0u, 0u, 0u, 0u}, rk1 = rk0, rv0 = rk0;
  const int nt = a.nkeys >> 6;
  const int krow0 = tid / KCH, kch0 = tid % KCH, krow1 = (tid + 512) / KCH, kch1 = (tid + 512) % KCH;
  const int vrow0 = tid >> 3, vch = tid & 7;
  const bool k1on = (NKC > 512) && (tid + 512 < NKC);
  auto gload = [&](int kt) {
    const int key0 = kt << 6;
    const bf16* kb; int ks;
    if (key0 < a.nsplit) { kb = a.Ka + (size_t)key0 * a.ksa; ks = a.ksa; } else { kb = a.Kb + (size_t)(key0 - a.nsplit) * a.ksb; ks = a.ksb; }
    gld16(rk0, kb + (size_t)krow0 * ks + kch0 * 8);
    if (k1on) gld16(rk1, kb + (size_t)krow1 * ks + kch1 * 8);
    gld16(rv0, a.Vt + (size_t)vrow0 * a.vs + key0 + vch * 8);
  };
  auto sstore = [&](int buf) {
    *(u32x4*)(Ks + (buf * 64 + krow0) * KROW + kch0 * 8) = rk0;
    if (k1on) *(u32x4*)(Ks + (buf * 64 + krow1) * KROW + kch1 * 8) = rk1;
    *(u32x4*)(Vs + (buf * 64 + vrow0) * 72 + vch * 8) = rv0;
  };
  __syncthreads();
  gload(0);
  asm volatile("s_waitcnt vmcnt(0)" : "+v"(rk0), "+v"(rk1), "+v"(rv0) : : "memory");
  sstore(0);
  constexpr bool T14 = KSPLIT;
  if (T14 && nt > 1) gload(1);
  __syncthreads();
  for (int kt = 0; kt < nt; ++kt) {
    const int buf = kt & 1;
    if constexpr (T14) {
      if (kt + 1 < nt) {
        asm volatile("s_waitcnt vmcnt(0)" : "+v"(rk0), "+v"(rk1), "+v"(rv0) : : "memory");
        sstore(buf ^ 1);
        if (kt + 2 < nt) gload(kt + 2);
      }
    } else {
      gload(kt + 1 < nt ? kt + 1 : kt);
    }
    if ((kt << 6) == a.nsplit) {
      const bf16* qa = a.QbA + (size_t)(wave * 32 + r) * a.qsb + 8 * h;
      const bf16* qb = a.QbB + (size_t)(wave * 32 + r) * a.qsb + 8 * h;
#pragma unroll
      for (int s = 0; s < NS; ++s) { qfA[s] = *(const bf16x8*)(qa + s * 16); qfB[s] = *(const bf16x8*)(qb + s * 16); }
    }
    f32x16 sA0, sA1, sB0, sB1;
#pragma unroll
    for (int e = 0; e < 16; ++e) { sA0[e] = 0.f; sA1[e] = 0.f; sB0[e] = 0.f; sB1[e] = 0.f; }
    const bf16* kp = Ks + (buf * 64 + pr) * KROW + 8 * h;
#pragma unroll
    for (int s = 0; s < NS; ++s) {
      bf16x8 k0 = *(const bf16x8*)(kp + s * 16), k1 = *(const bf16x8*)(kp + 32 * KROW + s * 16);
      sA0 = MFMA32(k0, qfA[s], sA0);
      sA1 = MFMA32(k1, qfA[s], sA1);
      if constexpr (KSPLIT) { k0 = *(const bf16x8*)(kp + DQK + s * 16); k1 = *(const bf16x8*)(kp + 32 * KROW + DQK + s * 16); }
      sB0 = MFMA32(k0, qfB[s], sB0);
      sB1 = MFMA32(k1, qfB[s], sB1);
    }
    const bf16* vp = Vs + (buf * 64 + r) * 72 + 8 * h;
    softmax_tile(sA0, sA1, mA, lA, oA0, oA1, a.c);
    pv_tile(sA0, sA1, vp, oA0, oA1);
    softmax_tile(sB0, sB1, mB, lB, oB0, oB1, a.c);
    pv_tile(sB0, sB1, vp, oB0, oB1);
    if constexpr (!T14) {
      asm volatile("s_waitcnt vmcnt(0)" : "+v"(rk0), "+v"(rk1), "+v"(rv0) : : "memory");
      sstore(buf ^ 1);
    }
    __syncthreads();
  }
  {
    const float invA = 1.f / (lA + __shfl_xor(lA, 32, 64)), invB = 1.f / (lB + __shfl_xor(lB, 32, 64));
#pragma unroll
    for (int e = 0; e < 16; ++e) { oA0[e] *= invA; oA1[e] *= invA; oB0[e] *= invB; oB1[e] *= invB; }
  }
}

template <int DQK>
DI void attn_kv2(const AttnArgs& a, char* smem, f32x16& o0, f32x16& o1) {
  constexpr int NS = DQK / 16;
  constexpr int KROW = DQK + 8;
  constexpr int KCH = DQK / 8;
  constexpr int NKC = 64 * KCH;
  constexpr int TILE_E = 64 * KROW + 64 * 72;
  bf16* T = (bf16*)smem;
  const int tid = get_tid(), lane = tid & 63, wave = tid >> 6;
  const int g = wave >> 2, qw = wave & 3;
  const int r = lane & 31, h = lane >> 5;
  const int pr = (r & ~12) | ((r & 4) << 1) | ((r & 8) >> 1);
  bf16x8 qf[NS];
  {
    const bf16* qp = a.Qa + (size_t)(qw * 32 + r) * a.qsa + 8 * h;
#pragma unroll
    for (int s = 0; s < NS; ++s) qf[s] = *(const bf16x8*)(qp + s * 16);
  }
#pragma unroll
  for (int e = 0; e < 16; ++e) { o0[e] = 0.f; o1[e] = 0.f; }
  float mrun = -1e30f, lrun = 0.f;
  u32x4 ka0 = {0u, 0u, 0u, 0u}, ka1 = ka0, va0 = ka0, kb0 = ka0, kb1 = ka0, vb0 = ka0;
  const int npair = a.nkeys >> 7, tsw = a.nsplit >> 6;
  const int krow0 = tid / KCH, kch0 = tid % KCH, krow1 = (tid + 512) / KCH, kch1 = (tid + 512) % KCH;
  const int vrow0 = tid >> 3, vch = tid & 7;
  const bool k0on = tid < NKC, k1on = (NKC > 512) && (tid + 512 < NKC);
  auto gload = [&](int j) {
    const int keyA = j << 7, keyB = keyA + 64;
    const bf16* kbA; int ksA; const bf16* kbB; int ksB;
    if (keyA < a.nsplit) { kbA = a.Ka + (size_t)keyA * a.ksa; ksA = a.ksa; } else { kbA = a.Kb + (size_t)(keyA - a.nsplit) * a.ksb; ksA = a.ksb; }
    if (keyB < a.nsplit) { kbB = a.Ka + (size_t)keyB * a.ksa; ksB = a.ksa; } else { kbB = a.Kb + (size_t)(keyB - a.nsplit) * a.ksb; ksB = a.ksb; }
    if (k0on) { gld16(ka0, kbA + (size_t)krow0 * ksA + kch0 * 8); gld16(kb0, kbB + (size_t)krow0 * ksB + kch0 * 8); }
    if (k1on) { gld16(ka1, kbA + (size_t)krow1 * ksA + kch1 * 8); gld16(kb1, kbB + (size_t)krow1 * ksB + kch1 * 8); }
    gld16(va0, a.Vt + (size_t)vrow0 * a.vs + keyA + vch * 8);
    gld16(vb0, a.Vt + (size_t)vrow0 * a.vs + keyB + vch * 8);
  };
  auto sstore = [&](int buf) {
    bf16* sa = T + (buf * 2) * TILE_E; bf16* sb = sa + TILE_E;
    if (k0on) { *(u32x4*)(sa + krow0 * KROW + kch0 * 8) = ka0; *(u32x4*)(sb + krow0 * KROW + kch0 * 8) = kb0; }
    if (k1on) { *(u32x4*)(sa + krow1 * KROW + kch1 * 8) = ka1; *(u32x4*)(sb + krow1 * KROW + kch1 * 8) = kb1; }
    *(u32x4*)(sa + 64 * KROW + vrow0 * 72 + vch * 8) = va0;
    *(u32x4*)(sb + 64 * KROW + vrow0 * 72 + vch * 8) = vb0;
  };
  __syncthreads();
  gload(0);
  asm volatile("s_waitcnt vmcnt(0)" : "+v"(ka0), "+v"(ka1), "+v"(va0), "+v"(kb0), "+v"(kb1), "+v"(vb0) : : "memory");
  sstore(0);
  if (npair > 1) gload(1);
  __syncthreads();
  for (int j = 0; j < npair; ++j) {
    const int buf = j & 1;
    if (j + 1 < npair) {
      asm volatile("s_waitcnt vmcnt(0)" : "+v"(ka0), "+v"(ka1), "+v"(va0), "+v"(kb0), "+v"(kb1), "+v"(vb0) : : "memory");
      sstore(buf ^ 1);
      if (j + 2 < npair) gload(j + 2);
    }
    if (2 * j == tsw) {
      const bf16* qp = a.Qb + (size_t)(qw * 32 + r) * a.qsb + 8 * h;
#pragma unroll
      for (int s = 0; s < NS; ++s) qf[s] = *(const bf16x8*)(qp + s * 16);
    }
    const bf16* slot = T + (buf * 2 + g) * TILE_E;
    f32x16 s0, s1;
#pragma unroll
    for (int e = 0; e < 16; ++e) { s0[e] = 0.f; s1[e] = 0.f; }
    const bf16* kp = slot + pr * KROW + 8 * h;
#pragma unroll
    for (int s = 0; s < NS; ++s) {
      bf16x8 k0 = *(const bf16x8*)(kp + s * 16), k1 = *(const bf16x8*)(kp + 32 * KROW + s * 16);
      s0 = MFMA32(k0, qf[s], s0);
      s1 = MFMA32(k1, qf[s], s1);
    }
    const bf16* vp = slot + 64 * KROW + r * 72 + 8 * h;
    softmax_tile(s0, s1, mrun, lrun, o0, o1, a.c);
    pv_tile(s0, s1, vp, o0, o1);
    __syncthreads();
  }
  const float lsum = lrun + __shfl_xor(lrun, 32, 64);
  float* mg = (float*)smem + (qw * 34) * 64 + lane;
  if (g == 1) {
#pragma unroll
    for (int e = 0; e < 16; ++e) { mg[e * 64] = o0[e]; mg[(16 + e) * 64] = o1[e]; }
    mg[32 * 64] = mrun; mg[33 * 64] = lsum;
  }
  __syncthreads();
  if (g == 0) {
    const float mB = mg[32 * 64], lB = mg[33 * 64];
    const float M = fmaxf(mrun, mB);
    const float fa = __builtin_amdgcn_exp2f(mrun - M), fb = __builtin_amdgcn_exp2f(mB - M);
    const float inv = 1.f / (lsum * fa + lB * fb);
#pragma unroll
    for (int e = 0; e < 16; ++e) {
      o0[e] = (o0[e] * fa + mg[e * 64] * fb) * inv;
      o1[e] = (o1[e] * fa + mg[(16 + e) * 64] * fb) * inv;
    }
  }
}

DI void write_o(bf16* dst, const f32x16& o0, const f32x16& o1, int h) {
#pragma unroll
  for (int g = 0; g < 4; ++g) {
    st4bf(dst + 8 * g + 4 * h, o0[4 * g], o0[4 * g + 1], o0[4 * g + 2], o0[4 * g + 3]);
    st4bf(dst + 32 + 8 * g + 4 * h, o1[4 * g], o1[4 * g + 1], o1[4 * g + 2], o1[4 * g + 3]);
  }
}

DI void convT_units(const float* __restrict__ src, int ldsrc, int srccol0, bf16* __restrict__ dst, int K, int N, int dstrow0, int unit) {
  const int n = unit % N, kc = unit / N;
  const float* s = src + (size_t)(kc * 8) * ldsrc + srccol0 + n;
  float v[8];
#pragma unroll
  for (int j = 0; j < 8; ++j) v[j] = s[(size_t)j * ldsrc];
  uint4 u; u.x = pack2(v[0], v[1]); u.y = pack2(v[2], v[3]); u.z = pack2(v[4], v[5]); u.w = pack2(v[6], v[7]);
  *(uint4*)(dst + (size_t)(dstrow0 + n) * K + kc * 8) = u;
}

DI int seg_src(int n) {
  if (n < 512) return n;
  if (n < 704) return 1024 + (n - 512);
  if (n < 832) return 1216 + (n - 704);
  if (n < 864) return 1344 + (n - 832);
  if (n < 1120) return 1376 + (n - 864);
  if (n < 1248) return 1632 + (n - 1120);
  if (n < 1280) return -1;
  if (n < 1536) return 512 + (n - 1280);
  return 1760 + (n - 1536);
}

DI void phase0(const Params& p, char* smem) {
  const int tid = get_tid();
  float* tab = (float*)smem;
  float* sil = tab + 4096;
  float* red = sil + 3072;
  for (int i = tid; i < 4096; i += NT) tab[i] = cospif((float)i * (1.0f / 2048.0f));
  for (int i = tid; i < 1024; i += NT) {
    float a = p.in[9][i], b = p.in[8][i], c = p.in[8][1024 + i];
    sil[i] = a / (1.f + __expf(-a)); sil[1024 + i] = b / (1.f + __expf(-b)); sil[2048 + i] = c / (1.f + __expf(-c));
  }
  __syncthreads();
  float* mods = (float*)(p.ws + OFF_MODS);
  constexpr int N_MODS = 192, N_MISC = 1;
  constexpr int U_WIN = 1792 * 128;
  constexpr int U_WPQ = 512 * 128;
  constexpr int U_WOUT = 1024 * 128, U_WUQ = 384 * 24, U_WUKV = 512 * 16;
  constexpr int I_WIN = 2 * U_WIN / NT, I_WPQ = 2 * U_WPQ / NT, I_WOUT = 2 * U_WOUT / NT, I_WUQ = 2 * U_WUQ / NT, I_WUKV = 2 * U_WUKV / NT;
  constexpr int I_DFTL = 0, I_DFTC = 256 * 64 / NT;
  constexpr int B0 = N_MODS, B1 = B0 + N_MISC, B2 = B1 + I_WIN, B3 = B2 + I_WPQ, B4 = B3 + I_WOUT, B5 = B4 + I_WUQ, B6 = B5 + I_WUKV, B7 = B6 + I_DFTL, B8 = B7 + I_DFTC;
  for (int it = blockIdx.x; it < B8; it += gridDim.x) {
    if (it < B0) {
      const int l = it / 96, cg = it % 96, j = tid & 63, kq = tid >> 6;
      const float* w = p.in[12] + ((size_t)l * 1024 + kq * 128) * 6144 + cg * 64 + j;
      float a0 = 0.f, a1 = 0.f, a2 = 0.f;
#pragma unroll 8
      for (int k = 0; k < 128; ++k) { const float wv = w[(size_t)k * 6144]; const int kk = kq * 128 + k; a0 += sil[kk] * wv; a1 += sil[1024 + kk] * wv; a2 += sil[2048 + kk] * wv; }
      red[(kq * 3 + 0) * 64 + j] = a0; red[(kq * 3 + 1) * 64 + j] = a1; red[(kq * 3 + 2) * 64 + j] = a2;
      __syncthreads();
      if (tid < 192) {
        const int w3 = tid >> 6, jj = tid & 63, col = cg * 64 + jj;
        float sum = 0.f;
#pragma unroll
        for (int q = 0; q < 8; ++q) sum += red[(q * 3 + w3) * 64 + jj];
        mods[(size_t)(l * 3 + w3) * 6144 + col] = sum + p.in[13][l * 6144 + col];
      }
      __syncthreads();
    } else if (it < B1) {
      float* lam = (float*)(p.ws + OFF_LAM);
      if (tid < 2) {
        const float* lp = p.in[15] + tid * 128;
        float d1 = 0.f, d2 = 0.f;
        for (int i = 0; i < 32; ++i) { d1 += lp[i] * lp[32 + i]; d2 += lp[64 + i] * lp[96 + i]; }
        const float li = 0.8f - 0.6f * expf(-0.3f * (float)tid);
        lam[tid * 2] = expf(d1) - expf(d2) + li;
        lam[tid * 2 + 1] = li;
      }
      float* t32 = (float*)(p.ws + OFF_TAB32);
      float* t64 = (float*)(p.ws + OFF_TAB64);
      for (int i = tid; i < 512; i += NT) {
        const int pos = i >> 3, pp = i & 7;
        const float inv = exp2f(-(float)pp * (13.287712379549449f / 8.f));
        const float ap = (float)pos * inv * 0.3183098861837907f;
        t32[i * 2] = cospif(ap); t32[i * 2 + 1] = sinpif(ap);
      }
      for (int i = tid; i < 1024; i += NT) {
        const int pos = i >> 4, pp = i & 15;
        const float inv = exp2f(-(float)pp * (13.287712379549449f / 16.f));
        const float ap = (float)pos * inv * 0.3183098861837907f;
        t64[i * 2] = cospif(ap); t64[i * 2 + 1] = sinpif(ap);
      }
    } else if (it < B2) {
      int u = (it - B1) * NT + tid;
      const int l = u / U_WIN; u -= l * U_WIN;
      const int n1 = u % 1792, kc = u / 1792;
      const int n = n1 < 1664 ? n1 : 2176 + (n1 - 1664);
      bf16* dst = (bf16*)(p.ws + OFF_WIN) + (size_t)l * 2304 * 1024;
      const int sc = n1 < 1664 ? seg_src(n) : -1;
      uint4 uu = {0u, 0u, 0u, 0u};
      if (sc >= 0) {
        const float* s = p.in[14] + (size_t)l * 1024 * 1888 + (size_t)(kc * 8) * 1888 + sc;
        float v[8];
#pragma unroll
        for (int j = 0; j < 8; ++j) v[j] = s[(size_t)j * 1888];
        uu.x = pack2(v[0], v[1]); uu.y = pack2(v[2], v[3]); uu.z = pack2(v[4], v[5]); uu.w = pack2(v[6], v[7]);
      }
      *(uint4*)(dst + (size_t)n * 1024 + kc * 8) = uu;
    } else if (it < B3) {
      const int q = it - B2, l = q >> 7, kc = q & 127;
      float* src = red + 1536;
      __syncthreads();
      {
        const int j = tid >> 6, c4 = (tid & 63) * 4;
        *(float4*)(src + j * 256 + c4) = *(const float4*)(p.in[14] + (size_t)l * 1024 * 1888 + (size_t)(kc * 8 + j) * 1888 + 768 + c4);
      }
      __syncthreads();
      const int nn = tid, isq = nn >> 8, g = (nn >> 6) & 3, m = nn & 63;
      float v[8] = {0.f, 0.f, 0.f, 0.f, 0.f, 0.f, 0.f, 0.f};
#pragma unroll 4
      for (int c = 0; c < 64; ++c) {
        const int idx = ((m * c) & 63) * 64 + (isq ? 3072 : 0);
        const float tw = tab[idx & 4095];
#pragma unroll
        for (int j = 0; j < 8; ++j) v[j] += src[j * 256 + g * 64 + c] * tw;
      }
      uint4 uu; uu.x = pack2(v[0], v[1]); uu.y = pack2(v[2], v[3]); uu.z = pack2(v[4], v[5]); uu.w = pack2(v[6], v[7]);
      bf16* dst = (bf16*)(p.ws + OFF_WIN) + (size_t)l * 2304 * 1024;
      *(uint4*)(dst + (size_t)(1664 + nn) * 1024 + kc * 8) = uu;
    } else if (it < B4) {
      int u = (it - B3) * NT + tid; const int l = u / U_WOUT; u -= l * U_WOUT;
      convT_units(p.in[23] + (size_t)l * 1024 * 1024, 1024, 0, (bf16*)(p.ws + OFF_WOUT) + (size_t)l * 1024 * 1024, 1024, 1024, 0, u);
    } else if (it < B5) {
      int u = (it - B4) * NT + tid; const int l = u / U_WUQ; u -= l * U_WUQ;
      convT_units(p.in[18] + (size_t)l * 192 * 384, 384, 0, (bf16*)(p.ws + OFF_WUQ) + (size_t)l * 384 * 192, 192, 384, 0, u);
    } else if (it < B6) {
      int u = (it - B5) * NT + tid; const int l = u / U_WUKV; u -= l * U_WUKV;
      convT_units(p.in[20] + (size_t)l * 128 * 512, 512, 0, (bf16*)(p.ws + OFF_WUKV) + (size_t)l * 512 * 128, 128, 512, 0, u);
    } else {
      const int u = (it - B7) * NT + tid;
      const int k = u >> 6, c0 = (u & 63) * 8;
      float v[8];
#pragma unroll
      for (int j = 0; j < 8; ++j) { const int col = c0 + j; const int s = col & 255; const int idx = (16 * ((k * s) & 255) + (col >= 256 ? 1024 : 0)) & 4095; v[j] = tab[idx] * (1.f / 128.f); }
      uint4 uu; uu.x = pack2(v[0], v[1]); uu.y = pack2(v[2], v[3]); uu.z = pack2(v[4], v[5]); uu.w = pack2(v[6], v[7]);
      *(uint4*)((bf16*)(p.ws + OFF_DFTC) + (size_t)k * 512 + c0) = uu;
    }
  }
}

constexpr int NRW = 4;
DI void modnorm_rows(const Params& p, int l, int item, const float* gvec, int ish, int isc) {
  const int tid_ = get_tid(); const int lane = tid_ & 63, wave = tid_ >> 6;
  const int t0 = item * (8 * NRW) + wave * NRW;
  float4 v[NRW][4];
  float ss[NRW];
  if (ish == 0 && l == 0) {
#pragma unroll
    for (int q = 0; q < NRW; ++q) {
      const float* x = xrow(p, 0, t0 + q);
#pragma unroll
      for (int i = 0; i < 4; ++i) v[q][i] = *(const float4*)(x + lane * 4 + 256 * i);
    }
  } else {
#pragma unroll
    for (int q = 0; q < NRW; ++q) {
      const bf16* x = (const bf16*)(p.ws + OFF_XRES) + (size_t)(t0 + q) * 1024;
#pragma unroll
      for (int i = 0; i < 4; ++i) {
        const uint2 u = *(const uint2*)(x + lane * 4 + 256 * i);
        v[q][i].x = __uint_as_float(u.x << 16); v[q][i].y = __uint_as_float(u.x & 0xffff0000u);
        v[q][i].z = __uint_as_float(u.y << 16); v[q][i].w = __uint_as_float(u.y & 0xffff0000u);
      }
    }
  }
#pragma unroll
  for (int q = 0; q < NRW; ++q) {
    ss[q] = 0.f;
#pragma unroll
    for (int i = 0; i < 4; ++i) ss[q] += v[q][i].x * v[q][i].x + v[q][i].y * v[q][i].y + v[q][i].z * v[q][i].z + v[q][i].w * v[q][i].w;
  }
  const int w = whichmod(t0);
  const float* sh = modp(p, l, w, ish);
  const float* sc = modp(p, l, w, isc);
  float4 gm[4], sf[4];
#pragma unroll
  for (int i = 0; i < 4; ++i) {
    const int n = lane * 4 + 256 * i;
    const float4 g = *(const float4*)(gvec + n), s1 = *(const float4*)(sc + n);
    sf[i] = *(const float4*)(sh + n);
    gm[i].x = g.x * (1.f + s1.x); gm[i].y = g.y * (1.f + s1.y); gm[i].z = g.z * (1.f + s1.z); gm[i].w = g.w * (1.f + s1.w);
  }
#pragma unroll
  for (int q = 0; q < NRW; ++q) ss[q] = wsum(ss[q]);
  bf16* hb = (bf16*)(p.ws + OFF_HBUF) + (size_t)t0 * 1024;
#pragma unroll
  for (int q = 0; q < NRW; ++q) {
    const float r = rsqrtf(ss[q] * (1.f / 1024.f) + 1e-6f);
#pragma unroll
    for (int i = 0; i < 4; ++i) {
      const int n = lane * 4 + 256 * i;
      st4bf(hb + (size_t)q * 1024 + n, v[q][i].x * r * gm[i].x + sf[i].x, v[q][i].y * r * gm[i].y + sf[i].y, v[q][i].z * r * gm[i].z + sf[i].z, v[q][i].w * r * gm[i].w + sf[i].w);
    }
  }
}

DI void phaseA(const Params& p, int l) {
  const int tid = get_tid();
  constexpr int I_ROWS = 2048 / NRW;
  constexpr int U_W1 = 4096 * 128, U_W2 = 1024 * 512;
  constexpr int I_W1 = 0, I_W2 = 0;
  constexpr int I_KDC = 32768 / NT, I_KGC = 16384 / NT, I_VTD = 32768 / NT, I_VTG = 16384 / NT, I_CKV = 16384 / NT, I_KR = 32768 / NT;
  constexpr int B0 = I_ROWS, B1 = B0 + I_W1, B2 = B1 + I_W2, B3 = B2 + I_KDC, B4 = B3 + I_KGC, B5 = B4 + I_VTD, B6 = B5 + I_VTG, B7 = B6 + I_CKV, B8 = B7 + I_KR;
  for (int it = blockIdx.x; it < B8; it += gridDim.x) {
    if (it < B0) {
      modnorm_rows(p, l, it, p.in[10] + l * 1024, 0, 1);
    } else if (it < B2) {
    } else if (it < B3) {
      const int u = (it - B2) * NT + tid;
      const int e0 = u * 8, b = e0 >> 17, rem = e0 & 131071;
      const float* s = p.in[2] + ((size_t)(b * 2 + l) * 512) * 256 + rem;
      const float4 x0 = *(const float4*)s, x1 = *(const float4*)(s + 4);
      uint4 uu; uu.x = pack2(x0.x, x0.y); uu.y = pack2(x0.z, x0.w); uu.z = pack2(x1.x, x1.y); uu.w = pack2(x1.z, x1.w);
      *(uint4*)((bf16*)(p.ws + OFF_KDC) + e0) = uu;
    } else if (it < B4) {
      const int u = (it - B3) * NT + tid;
      const int e0 = u * 8, b = e0 >> 16, rem = e0 & 65535;
      const float* s = p.in[6] + ((size_t)(b * 2 + l) * 512) * 128 + rem;
      const float4 x0 = *(const float4*)s, x1 = *(const float4*)(s + 4);
      uint4 uu; uu.x = pack2(x0.x, x0.y); uu.y = pack2(x0.z, x0.w); uu.z = pack2(x1.x, x1.y); uu.w = pack2(x1.z, x1.w);
      *(uint4*)((bf16*)(p.ws + OFF_KGC) + e0) = uu;
    } else if (it < B5) {
      const int u = (it - B4) * NT + tid;
      const int c = u & 255, jc = (u >> 8) & 63, b = u >> 14;
      const float* s = p.in[3] + ((size_t)(b * 2 + l) * 512 + jc * 8) * 256 + c;
      float v[8];
#pragma unroll
      for (int j = 0; j < 8; ++j) v[j] = s[j * 256];
      uint4 uu; uu.x = pack2(v[0], v[1]); uu.y = pack2(v[2], v[3]); uu.z = pack2(v[4], v[5]); uu.w = pack2(v[6], v[7]);
      *(uint4*)((bf16*)(p.ws + OFF_VTDL) + ((size_t)(b * 256 + c)) * 4608 + 4096 + jc * 8) = uu;
    } else if (it < B6) {
      const int u = (it - B5) * NT + tid;
      const int c = u & 127, jc = (u >> 7) & 63, b = u >> 13;
      const float* s = p.in[7] + ((size_t)(b * 2 + l) * 512 + jc * 8) * 128 + c;
      float v[8];
#pragma unroll
      for (int j = 0; j < 8; ++j) v[j] = s[j * 128];
      uint4 uu; uu.x = pack2(v[0], v[1]); uu.y = pack2(v[2], v[3]); uu.z = pack2(v[4], v[5]); uu.w = pack2(v[6], v[7]);
      *(uint4*)((bf16*)(p.ws + OFF_VTGL) + ((size_t)(b * 128 + c)) * 4608 + 4096 + jc * 8) = uu;
    } else if (it < B7) {
      const int u = (it - B6) * NT + tid;
      const int e0 = u * 8, b = e0 >> 16, rem = e0 & 65535, j = rem >> 7, e = rem & 127;
      const float* s = p.in[4] + ((size_t)(b * 2 + l) * 512) * 128 + rem;
      const float4 x0 = *(const float4*)s, x1 = *(const float4*)(s + 4);
      uint4 uu; uu.x = pack2(x0.x, x0.y); uu.y = pack2(x0.z, x0.w); uu.z = pack2(x1.x, x1.y); uu.w = pack2(x1.z, x1.w);
      *(uint4*)((bf16*)(p.ws + OFF_Z) + (size_t)(16384 + b * 512 + j) * ZLD + 704 + e) = uu;
    } else {
      const int u = (it - B7) * NT + tid;
      const int e = u & 31, j = (u >> 5) & 511, b = u >> 14;
      const bf16 v = f2bf(p.in[5][((size_t)(b * 2 + l) * 512 + j) * 32 + e]);
      bf16* km = (bf16*)(p.ws + OFF_KM) + (size_t)(16384 + b * 512 + j) * 384 + 64 + e;
      km[0] = v; km[96] = v; km[192] = v; km[288] = v;
    }
  }
}

DI void dft_lat_item(const Params& p, char* smem, int item, bool& tab_ready) {
  const int tid = get_tid();
  float* tab = (float*)smem;
  if (!tab_ready) {
    __syncthreads();
    for (int i = tid; i < 4096; i += NT) tab[i] = cospif((float)i * (1.0f / 2048.0f));
    __syncthreads();
    tab_ready = true;
  }
  for (int q = 0; q < 16; ++q) {
    const int u = (item * 16 + q) * NT + tid;
    const int k = u >> 10, c0 = (u & 1023) * 8;
    float v[8];
#pragma unroll
    for (int j = 0; j < 8; ++j) { const int col = c0 + j; const int s = col & 4095; const int idx = (k * s + (col >= 4096 ? 1024 : 0)) & 4095; v[j] = tab[idx] * (1.f / 512.f); }
    uint4 uu; uu.x = pack2(v[0], v[1]); uu.y = pack2(v[2], v[3]); uu.z = pack2(v[4], v[5]); uu.w = pack2(v[6], v[7]);
    *(uint4*)((bf16*)(p.ws + OFF_DFTL) + (size_t)k * 8192 + c0) = uu;
  }
}

DI void phaseB(const Params& p, int l, char* smem) {
  const bf16* A = (const bf16*)(p.ws + OFF_HBUF);
  const bf16* Bt = (const bf16*)(p.ws + OFF_WIN) + (size_t)l * 2304 * 1024;
  bf16* Z = (bf16*)(p.ws + OFF_Z);
  float* out = p.out;
  pg8::gemm_phase<true>((LAS unsigned char*)smem, A, Bt, 16384, 2048, 1024,
    [&](const pg8::f32x4 (&acc)[2][2][4][2], const pg8::Unit& u, int wr, int wc, int fr, int fq) {
      const int row0 = u.pm * 256 + wr * 64 + fr;
      const bool ctx = u.pm < 32;
#pragma unroll
      for (int bj = 0; bj < 2; ++bj) {
        const int c0 = u.pn * 256 + bj * 128 + wc * 32 + 8 * fq;
        if (c0 >= 2176) continue;
#pragma unroll
        for (int ai = 0; ai < 2; ++ai)
#pragma unroll
          for (int m = 0; m < 4; ++m) {
            const int row = row0 + ai * 128 + m * 16;
            const pg8::f32x4 v0 = acc[ai][bj][m][0], v1 = acc[ai][bj][m][1];
            if (c0 < 1280) {
              u32x4 w; w.x = pack2(v0[0], v0[1]); w.y = pack2(v0[2], v0[3]); w.z = pack2(v1[0], v1[1]); w.w = pack2(v1[2], v1[3]);
              *(u32x4*)(Z + (size_t)row * ZLD + c0) = w;
            } else {
              const int b = ctx ? (row >> 8) : ((row - 8192) >> 12);
              const int s = ctx ? (row & 255) : ((row - 8192) & 4095);
              const float vv[8] = {v0[0], v0[1], v0[2], v0[3], v1[0], v1[1], v1[2], v1[3]};
              bf16* dst; size_t cs;
              if (c0 < 1536) {
                const int c = c0 - 1280;
                if (ctx) { dst = (bf16*)(p.ws + OFF_VTDC) + (size_t)(b * 256 + c) * 256 + s; cs = 256;
                           float* o = out + O_DV + ((size_t)(b * 2 + l) * 256 + s) * 256 + c; *(pg8::f32x4*)o = v0; *(pg8::f32x4*)(o + 4) = v1; }
                else { dst = (bf16*)(p.ws + OFF_VTDL) + (size_t)(b * 256 + c) * 4608 + s; cs = 4608; }
              } else if (c0 < 1664) {
                const int c = c0 - 1536;
                if (ctx) { dst = (bf16*)(p.ws + OFF_VTGC) + (size_t)(b * 128 + c) * 256 + s; cs = 256;
                           float* o = out + O_GV + ((size_t)(b * 2 + l) * 256 + s) * 128 + c; *(pg8::f32x4*)o = v0; *(pg8::f32x4*)(o + 4) = v1; }
                else { dst = (bf16*)(p.ws + OFF_VTGL) + (size_t)(b * 128 + c) * 4608 + s; cs = 4608; }
              } else {
                const int c = c0 - 1664, isq = c >> 8, ch = c & 255;
                if (ctx) { dst = (bf16*)(p.ws + OFF_PQTC) + (size_t)(b * 256 + ch) * 512 + isq * 256 + s; cs = 512; }
                else { dst = (bf16*)(p.ws + OFF_PQTL) + (size_t)(b * 256 + ch) * 8192 + isq * 4096 + s; cs = 8192; }
              }
#pragma unroll
              for (int j = 0; j < 8; ++j) dst[(size_t)j * cs] = f2bf(vv[j]);
            }
          }
      }
    });
}

DI void wave_lds_fence() { asm volatile("s_waitcnt lgkmcnt(0)" ::: "memory"); }

DI float ropef(const float* x, int o1, int o2, float c, float s, bool second) { const float x1 = x[o1], x2 = x[o2]; return second ? (x1 * s + x2 * c) : (x1 * c - x2 * s); }

DI float rope_elem(const float* x, int i, int a  , const float* tab, int prow, int pcol) {
  const int half = i / a, idx = i % a, hp = a >> 1, pp = idx % hp, second = idx / hp;
  const int pos = half ? pcol : prow;
  const float c = tab[(pos * hp + pp) * 2], s = tab[(pos * hp + pp) * 2 + 1];
  const float x1 = x[half * a + pp], x2 = x[half * a + hp + pp];
  return second ? (x1 * s + x2 * c) : (x1 * c - x2 * s);
}

DI void phaseC(const Params& p, int l, char* smem) {
  __syncthreads();
  const int tid = get_tid(), lane = tid & 63, wave = tid >> 6;
  float* xs = (float*)smem + wave * 1280;
  bf16* Z = (bf16*)(p.ws + OFF_Z);
  bf16* QR = (bf16*)(p.ws + OFF_QROT);
  bf16* KM = (bf16*)(p.ws + OFF_KM);
  float* t32 = (float*)smem + 8 * 1280;
  float* t64 = t32 + 1024;
  for (int i = tid; i < 1024; i += NT) t32[i] = ((const float*)(p.ws + OFF_TAB32))[i];
  for (int i = tid; i < 2048; i += NT) t64[i] = ((const float*)(p.ws + OFF_TAB64))[i];
  const float gq0 = p.in[17][l * 192 + lane], gq1 = p.in[17][l * 192 + 64 + lane], gq2 = p.in[17][l * 192 + 128 + lane];
  const float gkv0 = p.in[19][l * 128 + lane], gkv1 = p.in[19][l * 128 + 64 + lane];
  const float ggq0 = p.in[21][l * 64 + lane], ggk0 = p.in[22][l * 64 + lane];
  __syncthreads();
  float* out = p.out;
  const int i32 = lane & 31, h32 = i32 >> 4, pp32 = i32 & 7, o1a = h32 * 16 + pp32, o2a = o1a + 8; const bool sec32 = ((i32 >> 3) & 1) != 0;
  const int h64 = lane >> 5, pp64 = lane & 15, o1b = h64 * 32 + pp64, o2b = o1b + 16; const bool sec64 = ((lane >> 4) & 1) != 0;
  uint4 n0 = {0u, 0u, 0u, 0u}, n1 = n0, n2 = n0;
  if (blockIdx.x < 2048) {
    const bf16* zf = Z + (size_t)(blockIdx.x * 8 + wave) * ZLD;
    n0 = *(const uint4*)(zf + lane * 8); n1 = *(const uint4*)(zf + (lane + 64) * 8);
    if (lane < 28) n2 = *(const uint4*)(zf + (lane + 128) * 8);
  }
  for (int it = blockIdx.x; it < 2048; it += gridDim.x) {
    const int t = it * 8 + wave;
    const bool ctx = t < 8192;
    const int b = ctx ? (t >> 8) : ((t - 8192) >> 12);
    const int s = ctx ? (t & 255) : ((t - 8192) & 4095);
    const int tl = t - 8192;
    const int prow = s >> 6, pcol = s & 63;
    bf16* z = Z + (size_t)t * ZLD;
    wave_lds_fence();
    {
      const uint4 uu[3] = {n0, n1, n2};
#pragma unroll
      for (int q = 0; q < 3; ++q) {
        if (q < 2 || lane < 28) {
          const uint4 u = uu[q];
          float* d = xs + (lane + 64 * q) * 8;
          d[0] = __uint_as_float(u.x << 16); d[1] = __uint_as_float(u.x & 0xffff0000u);
          d[2] = __uint_as_float(u.y << 16); d[3] = __uint_as_float(u.y & 0xffff0000u);
          d[4] = __uint_as_float(u.z << 16); d[5] = __uint_as_float(u.z & 0xffff0000u);
          d[6] = __uint_as_float(u.w << 16); d[7] = __uint_as_float(u.w & 0xffff0000u);
        }
      }
    }
    if (it + (int)gridDim.x < 2048) {
      const bf16* zf = Z + (size_t)((it + gridDim.x) * 8 + wave) * ZLD;
      n0 = *(const uint4*)(zf + lane * 8); n1 = *(const uint4*)(zf + (lane + 64) * 8);
      if (lane < 28) n2 = *(const uint4*)(zf + (lane + 128) * 8);
    }
    wave_lds_fence();
    const size_t srow = (size_t)(b * 2 + l) * 256 + s;
    const int pos32 = h32 ? pcol : prow, pos64 = h64 ? pcol : prow;
    const float c32 = t32[(pos32 * 8 + pp32) * 2], s32 = t32[(pos32 * 8 + pp32) * 2 + 1];
    const float c64 = t64[(pos64 * 16 + pp64) * 2], s64 = t64[(pos64 * 16 + pp64) * 2 + 1];
#pragma unroll
    for (int j = 0; j < 4; ++j) {
      const int e = lane + 64 * j, m = e >> 5, i = e & 31;
      if (ctx) {
        out[O_DK + srow * 256 + e] = xs[256 + e];
      } else {
        QR[(size_t)tl * 512 + e] = f2bf(ropef(xs + m * 32, o1a, o2a, c32, s32, sec32));
        z[256 + e] = f2bf(ropef(xs + 256 + m * 32, o1a, o2a, c32, s32, sec32));
      }
    }
    {
      float v0 = xs[512 + lane], v1 = xs[576 + lane], v2 = xs[640 + lane];
      const float ss = wsum(v0 * v0 + v1 * v1 + v2 * v2);
      const float rstd = rsqrtf(ss * (1.f / 192.f) + 1e-6f);
      z[512 + lane] = f2bf(v0 * rstd * gq0); z[576 + lane] = f2bf(v1 * rstd * gq1); z[640 + lane] = f2bf(v2 * rstd * gq2);
    }
    {
      float v0 = xs[704 + lane], v1 = xs[768 + lane];
      const float ss = wsum(v0 * v0 + v1 * v1);
      const float rstd = rsqrtf(ss * (1.f / 128.f) + 1e-6f);
      v0 = v0 * rstd * gkv0; v1 = v1 * rstd * gkv1;
      z[704 + lane] = f2bf(v0); z[768 + lane] = f2bf(v1);
      if (ctx) { out[O_CKV + srow * 128 + lane] = v0; out[O_CKV + srow * 128 + 64 + lane] = v1; }
    }
    {
      const int e = lane & 31, hh = (lane >> 5) * 2;
      float v;
      if (ctx) { v = xs[832 + e]; if (lane < 32) out[O_KR + srow * 32 + e] = v; }
      else v = ropef(xs + 832, o1a, o2a, c32, s32, sec32);
      const bf16 bv = f2bf(v);
      KM[(size_t)t * 384 + hh * 96 + 64 + e] = bv;
      KM[(size_t)t * 384 + (hh + 1) * 96 + 64 + e] = bv;
    }
    float nq[4], nk[2];
#pragma unroll
    for (int hh = 0; hh < 4; ++hh) {
      const float v = xs[864 + hh * 64 + lane];
      const float ss = wsum(v * v);
      nq[hh] = v * rsqrtf(ss * (1.f / 64.f) + 1e-6f) * ggq0;
    }
#pragma unroll
    for (int hh = 0; hh < 2; ++hh) {
      const float v = xs[1120 + hh * 64 + lane];
      const float ss = wsum(v * v);
      nk[hh] = v * rsqrtf(ss * (1.f / 64.f) + 1e-6f) * ggk0;
    }
    wave_lds_fence();
#pragma unroll
    for (int hh = 0; hh < 4; ++hh) xs[864 + hh * 64 + lane] = nq[hh];
#pragma unroll
    for (int hh = 0; hh < 2; ++hh) xs[1120 + hh * 64 + lane] = nk[hh];
    wave_lds_fence();
#pragma unroll
    for (int hh = 0; hh < 4; ++hh) {
      z[864 + hh * 64 + lane] = f2bf(nq[hh]);
      if (!ctx) QR[(size_t)tl * 512 + 256 + hh * 64 + lane] = f2bf(ropef(xs + 864 + hh * 64, o1b, o2b, c64, s64, sec64));
    }
#pragma unroll
    for (int hh = 0; hh < 2; ++hh) {
      if (ctx) { z[1120 + hh * 64 + lane] = f2bf(nk[hh]); out[O_GK + srow * 128 + hh * 64 + lane] = nk[hh]; }
      else z[1120 + hh * 64 + lane] = f2bf(ropef(xs + 1120 + hh * 64, o1b, o2b, c64, s64, sec64));
    }
  }
}

DI void phaseD(const Params& p, int l, char* smem) {
  const bf16* Z = (const bf16*)(p.ws + OFF_Z);
  const bf16* Wuq = (const bf16*)(p.ws + OFF_WUQ) + (size_t)l * 384 * 192;
  const bf16* Wukv = (const bf16*)(p.ws + OFF_WUKV) + (size_t)l * 512 * 128;
  bf16* QMP = (bf16*)(p.ws + OFF_QMP); bf16* QMR = (bf16*)(p.ws + OFF_QMR);
  bf16* KM = (bf16*)(p.ws + OFF_KM);
  bf16* vtmc = (bf16*)(p.ws + OFF_VTMC); bf16* vtml = (bf16*)(p.ws + OFF_VTML);
  const float* t32 = (const float*)(p.ws + OFF_TAB32);
  constexpr int N0 = 128, N1 = 64 * 3, N2 = 68 * 4;
  const int NDFT = (l == 0) ? 256 : 0;
  const int tid = get_tid();
  int* ctr = (int*)(p.ws + OFF_CTR) + 4 + l;
  int* sitem = (int*)(smem + 131072);
  bool tab_ready = false;
  for (;;) {
    __syncthreads();
    if (tid == 0) *sitem = atomicAdd(ctr, 1);
    __syncthreads();
    int it = __builtin_amdgcn_readfirstlane(*sitem);
    if (it >= N0 + NDFT + N1 + N2) break;
    if (it < N0) {
      const int mt = it >> 1, nh = it & 1;
      gemm_tile_n64((const bf16*)(p.ws + OFF_HBUF), 1024, (const bf16*)(p.ws + OFF_WIN) + ((size_t)l * 2304 + 2048) * 1024, 1024, 1024, mt * 256, nh * 64, smem,
                [&](int m, int n, float v0, float v1, float v2, float v3) {
                  const bool ctx = m < 8192;
                  const int b = ctx ? (m >> 8) : ((m - 8192) >> 12);
                  const int s = ctx ? (m & 255) : ((m - 8192) & 4095);
                  const int ch = 128 + n;
                  if (ctx) st4bf((bf16*)(p.ws + OFF_PQTC) + (size_t)(b * 256 + ch) * 512 + 256 + s, v0, v1, v2, v3);
                  else st4bf((bf16*)(p.ws + OFF_PQTL) + (size_t)(b * 256 + ch) * 8192 + 4096 + s, v0, v1, v2, v3);
                });
      tab_ready = false;
      continue;
    }
    it -= N0;
    if (it < NDFT) { dft_lat_item(p, smem, it, tab_ready); continue; }
    it -= NDFT;
    tab_ready = false;
    if (it < N1) {
      const int mt = it / 3, nt = it % 3;
      gemm_tile(Z + 512, ZLD, Wuq, 192, 192, mt * 256, nt * 128, smem, [&](int m, int n, float v0, float v1, float v2, float v3) {
        bf16* q = QMP + (size_t)m * 384 + n;
        q[0] = f2bf(v0); q[384] = f2bf(v1); q[768] = f2bf(v2); q[1152] = f2bf(v3);
        const float p0 = __shfl_xor(v0, 8, 64), p1 = __shfl_xor(v1, 8, 64), p2 = __shfl_xor(v2, 8, 64), p3 = __shfl_xor(v3, 8, 64);
        if (m >= 8192) {
          const int w = n % 96;
          float r0 = v0, r1 = v1, r2 = v2, r3 = v3;
          if (w >= 64) {
            const int i = w - 64, half = i >> 4, pp = i & 7, second = (i >> 3) & 1;
            float vv[4] = {v0, v1, v2, v3}, pv[4] = {p0, p1, p2, p3}, rr[4];
#pragma unroll
            for (int ii = 0; ii < 4; ++ii) {
              const int s = (m + ii - 8192) & 4095;
              const int pos = half ? (s & 63) : (s >> 6);
              const float c = t32[(pos * 8 + pp) * 2], sn = t32[(pos * 8 + pp) * 2 + 1];
              rr[ii] = second ? (pv[ii] * sn + vv[ii] * c) : (vv[ii] * c - pv[ii] * sn);
            }
            r0 = rr[0]; r1 = rr[1]; r2 = rr[2]; r3 = rr[3];
          }
          bf16* qr = QMR + (size_t)(m - 8192) * 384 + n;
          qr[0] = f2bf(r0); qr[384] = f2bf(r1); qr[768] = f2bf(r2); qr[1152] = f2bf(r3);
        }
      });
    } else {
      const int i2 = it - N1, mt = i2 >> 2, nt = i2 & 3;
      gemm_tile(Z + 704, ZLD, Wukv, 128, 128, mt * 256, nt * 128, smem, [&](int m, int n, float v0, float v1, float v2, float v3) {
        const int hd = n >> 7, w = n & 127;
        if (w < 64) {
          bf16* k = KM + (size_t)m * 384 + hd * 96 + w;
          k[0] = f2bf(v0); k[384] = f2bf(v1); k[768] = f2bf(v2); k[1152] = f2bf(v3);
        } else {
          const int dv = w - 64;
          if (m < 8192) {
            const int b = m >> 8, key = m & 255;
            st4bf(vtmc + ((size_t)((b * 4 + hd) * 64 + dv)) * 256 + key, v0, v1, v2, v3);
          } else {
            int b, key;
            if (m < 16384) { b = (m - 8192) >> 12; key = (m - 8192) & 4095; } else { b = (m - 16384) >> 9; key = 4096 + ((m - 16384) & 511); }
            st4bf(vtml + ((size_t)((b * 4 + hd) * 64 + dv)) * 4608 + key, v0, v1, v2, v3);
          }
        }
      });
    }
  }
}

DI void phaseE(const Params& p, int l, char* smem) {
  const int tid = get_tid(), lane = tid & 63, wave = tid >> 6, r = lane & 31, h = lane >> 5;
  int* ctr = (int*)(p.ws + OFF_CTR) + l;
  int* sitem = (int*)(smem + 131072);
  bf16* Z = (bf16*)(p.ws + OFF_Z);
  bf16* QR = (bf16*)(p.ws + OFF_QROT);
  bf16* QMP = (bf16*)(p.ws + OFF_QMP); bf16* QMR = (bf16*)(p.ws + OFF_QMR);
  bf16* KM = (bf16*)(p.ws + OFF_KM);
  bf16* ymix = (bf16*)(p.ws + OFF_HBUF);
  constexpr float LOG2E = 1.4426950408889634f;
  constexpr int N_ATT = 1024, I_W1 = 4096 * 128 / NT, I_W2 = 1024 * 512 / NT;
  constexpr int NITEMS = N_ATT + I_W1 + I_W2;
  for (;;) {
    __syncthreads();
    if (tid == 0) *sitem = atomicAdd(ctr, 1);
    __syncthreads();
    const int it = __builtin_amdgcn_readfirstlane(*sitem);
    if (it >= NITEMS) break;
    if (it >= N_ATT) {
      if (it < N_ATT + I_W1) convT_units(p.in[24] + (size_t)l * 1024 * 4096, 4096, 0, (bf16*)(p.ws + OFF_W1), 1024, 4096, 0, (it - N_ATT) * NT + tid);
      else convT_units(p.in[25] + (size_t)l * 4096 * 1024, 1024, 0, (bf16*)(p.ws + OFF_W2), 4096, 1024, 0, (it - N_ATT - I_W1) * NT + tid);
    } else if (it >= 64 && it < 96) {
      const int q = it - 64, b = q >> 4, mt = (q >> 1) & 7, nt = q & 1;
      bf16* yb = ymix + (size_t)(8192 + b * 4096) * 1024 + 256;
      gemm_tile_dual((const bf16*)(p.ws + OFF_DFTL), 8192, (const bf16*)(p.ws + OFF_PQTL) + (size_t)b * 256 * 8192, 8192, 8192, mt * 256, nt * 128, smem,
                     [&](int m, int n, float c, float sn) {
                       yb[(size_t)m * 1024 + n] = f2bf(c + sn);
                       if (m > 0) yb[(size_t)(4096 - m) * 1024 + n] = f2bf(c - sn);
                     });
    } else if (it >= 96 && it < 128) {
      const int t2 = get_tid();
      const int wave2 = t2 >> 6, lane2 = t2 & 63;
      const int q = (it - 96) * 8 + wave2, b = q >> 7, ch0 = (q & 127) * 2;
#pragma unroll
      for (int cc = 0; cc < 2; ++cc) {
        const int ch = ch0 + cc;
        const bf16* pr = (const bf16*)(p.ws + OFF_PQTL) + (size_t)(b * 256 + ch) * 8192;
        float acc = 0.f;
#pragma unroll
        for (int i = 0; i < 8; ++i) {
          const uint4 u = *(const uint4*)(pr + (i * 64 + lane2) * 8);
          acc += __uint_as_float(u.x << 16) - __uint_as_float(u.x & 0xffff0000u) + __uint_as_float(u.y << 16) - __uint_as_float(u.y & 0xffff0000u)
               + __uint_as_float(u.z << 16) - __uint_as_float(u.z & 0xffff0000u) + __uint_as_float(u.w << 16) - __uint_as_float(u.w & 0xffff0000u);
        }
        acc = wsum(acc);
        if (lane2 == 0) ymix[(size_t)(8192 + b * 4096 + 2048) * 1024 + 256 + ch] = f2bf(acc * (1.f / 512.f));
      }
    } else if (it >= 960) {
      const int idx = it - 960, b = idx >> 1, nt = idx & 1;
      gemm_tile((const bf16*)(p.ws + OFF_DFTC), 512, (const bf16*)(p.ws + OFF_PQTC) + (size_t)b * 256 * 512, 512, 512, 0, nt * 128, smem,
                [&](int m, int n, float v0, float v1, float v2, float v3) {
                  bf16* y = ymix + (size_t)(b * 256 + m) * 1024 + 256 + n;
                  y[0] = f2bf(v0); y[1024] = f2bf(v1); y[2048] = f2bf(v2); y[3072] = f2bf(v3);
                });
    } else if ((it >= 256 && it < 512) || (it >= 640 && it < 896)) {
      const bool lat = it < 512;
      const int q = lat ? (it - 256) : (it - 640);
      int b, hd, qb;
      if (lat) { b = q >> 7; hd = (q >> 5) & 3; qb = q & 31; } else { b = q >> 3; hd = (q >> 1) & 3; qb = q & 1; }
      const int tb = lat ? (8192 + b * 4096) : (b * 256), t0 = tb + qb * 128, tl0 = t0 - 8192;
      AttnArgs a;
      a.nkeys = lat ? 4608 : 256; a.nsplit = lat ? 4096 : 256; a.vs = a.nkeys; a.c = 0.10206207261596575f * LOG2E;
      a.Vt = (lat ? (const bf16*)(p.ws + OFF_VTML) + (size_t)((b * 4 + hd) * 64) * 4608 : (const bf16*)(p.ws + OFF_VTMC) + (size_t)((b * 4 + hd) * 64) * 256);
      if (lat) { a.Qa = QMR + (size_t)tl0 * 384 + hd * 96; a.Qb = QMP + (size_t)t0 * 384 + hd * 96; }
      else { a.Qa = QMP + (size_t)t0 * 384 + hd * 96; a.Qb = a.Qa; }
      a.qsa = 384; a.qsb = 384;
      a.Ka = KM + (size_t)tb * 384 + hd * 96; a.ksa = 384;
      a.Kb = KM + (size_t)(16384 + b * 512) * 384 + hd * 96; a.ksb = 384;
      f32x16 o0, o1;
      attn_kv2<96>(a, smem, o0, o1);
      if (wave < 4) write_o(ymix + (size_t)(t0 + wave * 32 + r) * 1024 + 512 + hd * 64, o0, o1, h);
    } else {
      AttnArgs2 a;
      f32x16 oA0, oA1, oB0, oB1;
      if (false) {
      } else if (it < 64 || (it >= 896 && it < 960)) {
        const bool lat = it < 64;
        int b, kvh, qb;
        if (lat) { const int q = it; b = q >> 5; kvh = (q >> 4) & 1; qb = q & 15; } else { const int q = it - 896; b = q >> 1; kvh = q & 1; qb = 0; }
        const int tb = lat ? (8192 + b * 4096) : (b * 256), t0 = tb + qb * 256, tl0 = t0 - 8192;
        a.nkeys = lat ? 4608 : 256; a.nsplit = lat ? 4096 : 256; a.vs = a.nkeys; a.c = 0.125f * LOG2E;
        a.Vt = (lat ? (const bf16*)(p.ws + OFF_VTGL) + (size_t)((b * 2 + kvh) * 64) * 4608 : (const bf16*)(p.ws + OFF_VTGC) + (size_t)((b * 2 + kvh) * 64) * 256);
        const int hA = kvh * 2;
        if (lat) { a.QaA = QR + (size_t)tl0 * 512 + 256 + hA * 64; a.qsa = 512; a.QbA = Z + (size_t)t0 * ZLD + 864 + hA * 64; a.qsb = ZLD; }
        else { a.QaA = Z + (size_t)t0 * ZLD + 864 + hA * 64; a.qsa = ZLD; a.QbA = a.QaA; a.qsb = ZLD; }
        a.QaB = a.QaA + 64; a.QbB = a.QbA + 64;
        a.Ka = Z + (size_t)tb * ZLD + 1120 + kvh * 64; a.ksa = ZLD;
        a.Kb = (const bf16*)(p.ws + OFF_KGC) + (size_t)(b * 512) * 128 + kvh * 64; a.ksb = 128;
        attn_dual<64, false>(a, smem, oA0, oA1, oB0, oB1);
        bf16* yd = ymix + (size_t)(t0 + wave * 32 + r) * 1024 + 768 + hA * 64;
        write_o(yd, oA0, oA1, h);
        write_o(yd + 64, oB0, oB1, h);
      } else {
        const bool lat = it < 256;
        int b, hd, qb;
        if (lat) { const int q = it - 128; b = q >> 6; hd = (q >> 4) & 3; qb = q & 15; } else { const int q = it - 512; b = q >> 2; hd = q & 3; qb = 0; }
        const int tb = lat ? (8192 + b * 4096) : (b * 256), t0 = tb + qb * 256, tl0 = t0 - 8192;
        a.nkeys = lat ? 4608 : 256; a.nsplit = lat ? 4096 : 256; a.vs = a.nkeys; a.c = 0.17677669529663687f * LOG2E;
        a.Vt = (lat ? (const bf16*)(p.ws + OFF_VTDL) + (size_t)((b * 4 + hd) * 64) * 4608 : (const bf16*)(p.ws + OFF_VTDC) + (size_t)((b * 4 + hd) * 64) * 256);
        if (lat) { a.QaA = QR + (size_t)tl0 * 512 + hd * 64; a.qsa = 512; a.QbA = Z + (size_t)t0 * ZLD + hd * 64; a.qsb = ZLD; }
        else { a.QaA = Z + (size_t)t0 * ZLD + hd * 64; a.qsa = ZLD; a.QbA = a.QaA; a.qsb = ZLD; }
        a.QaB = a.QaA + 32; a.QbB = a.QbA + 32;
        a.Ka = Z + (size_t)tb * ZLD + 256 + hd * 64; a.ksa = ZLD;
        a.Kb = (const bf16*)(p.ws + OFF_KDC) + (size_t)(b * 512) * 256 + hd * 64; a.ksb = 256;
        attn_dual<32, true>(a, smem, oA0, oA1, oB0, oB1);
        const float lam = ((const float*)(p.ws + OFF_LAM))[l * 2], lam_init = ((const float*)(p.ws + OFF_LAM))[l * 2 + 1];
        const float* subg = p.in[16] + l * 64;
        float ss = 0.f;
#pragma unroll
        for (int e = 0; e < 16; ++e) { oA0[e] -= lam * oB0[e]; oA1[e] -= lam * oB1[e]; ss += oA0[e] * oA0[e] + oA1[e] * oA1[e]; }
        ss += __shfl_xor(ss, 32, 64);
        const float rstd = rsqrtf(ss * (1.f / 64.f) + 1e-6f) * (1.f - lam_init);
#pragma unroll
        for (int e = 0; e < 16; ++e) {
          const int dv = (e & 3) + 8 * (e >> 2) + 4 * h;
          oA0[e] *= rstd * subg[dv]; oA1[e] *= rstd * subg[32 + dv];
        }
        write_o(ymix + (size_t)(t0 + wave * 32 + r) * 1024 + hd * 64, oA0, oA1, h);
      }
    }
  }
}

DI pg8::f32x4 bf4lo(const u32x4& w) { return (pg8::f32x4){__uint_as_float(w.x << 16), __uint_as_float(w.x & 0xffff0000u), __uint_as_float(w.y << 16), __uint_as_float(w.y & 0xffff0000u)}; }
DI pg8::f32x4 bf4hi(const u32x4& w) { return (pg8::f32x4){__uint_as_float(w.z << 16), __uint_as_float(w.z & 0xffff0000u), __uint_as_float(w.w << 16), __uint_as_float(w.w & 0xffff0000u)}; }

DI void phaseF(const Params& p, int l, char* smem) {
  const bf16* A = (const bf16*)(p.ws + OFF_HBUF);
  const bf16* Bt = (const bf16*)(p.ws + OFF_WOUT) + (size_t)l * 1024 * 1024;
  bf16* xres = (bf16*)(p.ws + OFF_XRES);
  pg8::gemm_phase<true>((LAS unsigned char*)smem, A, Bt, 16384, 1024, 1024,
    [&](const pg8::f32x4 (&acc)[2][2][4][2], const pg8::Unit& u, int wr, int wc, int fr, int fq) {
      const int row0 = u.pm * 256 + wr * 64 + fr, col0 = u.pn * 256 + wc * 32 + 8 * fq;
      const float* g1 = modp(p, l, whichmod(u.pm * 256), 2);
      pg8::f32x4 ga[2], gb[2];
#pragma unroll
      for (int bj = 0; bj < 2; ++bj) { ga[bj] = *(const pg8::f32x4*)(g1 + col0 + bj * 128); gb[bj] = *(const pg8::f32x4*)(g1 + col0 + bj * 128 + 4); }
      if (l == 0) {
#pragma unroll
        for (int ai = 0; ai < 2; ++ai)
#pragma unroll
          for (int mh = 0; mh < 2; ++mh) {
            pg8::f32x4 xa[2][2], xb[2][2];
#pragma unroll
            for (int m2 = 0; m2 < 2; ++m2)
#pragma unroll
              for (int bj = 0; bj < 2; ++bj) {
                const float* xr = xrow(p, 0, row0 + ai * 128 + (mh * 2 + m2) * 16) + col0 + bj * 128;
                xa[m2][bj] = *(const pg8::f32x4*)xr; xb[m2][bj] = *(const pg8::f32x4*)(xr + 4);
              }
#pragma unroll
            for (int m2 = 0; m2 < 2; ++m2)
#pragma unroll
              for (int bj = 0; bj < 2; ++bj) {
                const int m = mh * 2 + m2;
                const pg8::f32x4 ya = xa[m2][bj] + ga[bj] * acc[ai][bj][m][0], yb = xb[m2][bj] + gb[bj] * acc[ai][bj][m][1];
                u32x4 o; o.x = pack2(ya[0], ya[1]); o.y = pack2(ya[2], ya[3]); o.z = pack2(yb[0], yb[1]); o.w = pack2(yb[2], yb[3]);
                *(u32x4*)(xres + (size_t)(row0 + ai * 128 + m * 16) * 1024 + col0 + bj * 128) = o;
              }
          }
      } else {
#pragma unroll
        for (int ai = 0; ai < 2; ++ai) {
          u32x4 w[4][2];
#pragma unroll
          for (int m = 0; m < 4; ++m)
#pragma unroll
            for (int bj = 0; bj < 2; ++bj) w[m][bj] = *(const u32x4*)(xres + (size_t)(row0 + ai * 128 + m * 16) * 1024 + col0 + bj * 128);
#pragma unroll
          for (int m = 0; m < 4; ++m)
#pragma unroll
            for (int bj = 0; bj < 2; ++bj) {
              const pg8::f32x4 ya = bf4lo(w[m][bj]) + ga[bj] * acc[ai][bj][m][0], yb = bf4hi(w[m][bj]) + gb[bj] * acc[ai][bj][m][1];
              u32x4 o; o.x = pack2(ya[0], ya[1]); o.y = pack2(ya[2], ya[3]); o.z = pack2(yb[0], yb[1]); o.w = pack2(yb[2], yb[3]);
              *(u32x4*)(xres + (size_t)(row0 + ai * 128 + m * 16) * 1024 + col0 + bj * 128) = o;
            }
        }
      }
    });
}

DI void phaseG(const Params& p, int l) {
  for (int it = blockIdx.x; it < 2048 / NRW; it += gridDim.x) modnorm_rows(p, l, it, p.in[11] + l * 1024, 3, 4);
}

DI void phaseH(const Params& p, char* smem) {
  const bf16* A = (const bf16*)(p.ws + OFF_HBUF);
  const bf16* Bt = (const bf16*)(p.ws + OFF_W1);
  bf16* ab = (bf16*)(p.ws + OFF_A);
  pg8::gemm_phase<true>((LAS unsigned char*)smem, A, Bt, 16384, 4096, 1024,
    [&](const pg8::f32x4 (&acc)[2][2][4][2], const pg8::Unit& u, int wr, int wc, int fr, int fq) {
      const int row0 = u.pm * 256 + wr * 64 + fr, col0 = u.pn * 256 + wc * 32 + 8 * fq;
#pragma unroll
      for (int ai = 0; ai < 2; ++ai)
#pragma unroll
        for (int m = 0; m < 4; ++m) {
          bf16* rowp = ab + (size_t)(row0 + ai * 128 + m * 16) * 4096 + col0;
#pragma unroll
          for (int bj = 0; bj < 2; ++bj) {
            pg8::f32x4 v0 = acc[ai][bj][m][0], v1 = acc[ai][bj][m][1];
#pragma unroll
            for (int j = 0; j < 4; ++j) { v0[j] = fmaxf(v0[j], 0.f); v0[j] *= v0[j]; v1[j] = fmaxf(v1[j], 0.f); v1[j] *= v1[j]; }
            u32x4 w; w.x = pack2(v0[0], v0[1]); w.y = pack2(v0[2], v0[3]); w.z = pack2(v1[0], v1[1]); w.w = pack2(v1[2], v1[3]);
            *(u32x4*)(rowp + bj * 128) = w;
          }
        }
    });
}

DI void phaseI(const Params& p, int l, char* smem) {
  const bf16* A = (const bf16*)(p.ws + OFF_A);
  const bf16* Bt = (const bf16*)(p.ws + OFF_W2);
  bf16* xres = (bf16*)(p.ws + OFF_XRES);
  pg8::gemm_phase<true>((LAS unsigned char*)smem, A, Bt, 16384, 1024, 4096,
    [&](const pg8::f32x4 (&acc)[2][2][4][2], const pg8::Unit& u, int wr, int wc, int fr, int fq) {
      const int row0 = u.pm * 256 + wr * 64 + fr, col0 = u.pn * 256 + wc * 32 + 8 * fq;
      const float* g2 = modp(p, l, whichmod(u.pm * 256), 5);
      pg8::f32x4 ga[2], gb[2];
#pragma unroll
      for (int bj = 0; bj < 2; ++bj) { ga[bj] = *(const pg8::f32x4*)(g2 + col0 + bj * 128); gb[bj] = *(const pg8::f32x4*)(g2 + col0 + bj * 128 + 4); }
#pragma unroll
      for (int ai = 0; ai < 2; ++ai) {
        u32x4 w[4][2];
#pragma unroll
        for (int m = 0; m < 4; ++m)
#pragma unroll
          for (int bj = 0; bj < 2; ++bj) w[m][bj] = *(const u32x4*)(xres + (size_t)(row0 + ai * 128 + m * 16) * 1024 + col0 + bj * 128);
#pragma unroll
        for (int m = 0; m < 4; ++m)
#pragma unroll
          for (int bj = 0; bj < 2; ++bj) {
            const pg8::f32x4 ya = bf4lo(w[m][bj]) + ga[bj] * acc[ai][bj][m][0], yb = bf4hi(w[m][bj]) + gb[bj] * acc[ai][bj][m][1];
            u32x4 o; o.x = pack2(ya[0], ya[1]); o.y = pack2(ya[2], ya[3]); o.z = pack2(yb[0], yb[1]); o.w = pack2(yb[2], yb[3]);
            *(u32x4*)(xres + (size_t)(row0 + ai * 128 + m * 16) * 1024 + col0 + bj * 128) = o;
          }
      }
    });
}

DI void phaseZ(const Params& p) {
  const int tid_ = get_tid(); const int lane = tid_ & 63, wave = tid_ >> 6;
  const float* g = p.in[26];
  float4 gg4[4];
#pragma unroll
  for (int i = 0; i < 4; ++i) gg4[i] = *(const float4*)(g + lane * 4 + 256 * i);
  for (int it = blockIdx.x; it < 1024; it += gridDim.x) {
    const int t0 = it * 16 + wave * 2;
    const bf16* xa = (const bf16*)(p.ws + OFF_XRES) + (size_t)t0 * 1024;
    const bf16* xb = xa + 1024;
    float* ya = p.out + (size_t)t0 * 1024;
    float* yb = ya + 1024;
    float4 va[4], vb[4];
    float sa = 0.f, sb = 0.f;
#pragma unroll
    for (int i = 0; i < 4; ++i) {
      const uint2 ua = *(const uint2*)(xa + lane * 4 + 256 * i), ub = *(const uint2*)(xb + lane * 4 + 256 * i);
      va[i].x = __uint_as_float(ua.x << 16); va[i].y = __uint_as_float(ua.x & 0xffff0000u); va[i].z = __uint_as_float(ua.y << 16); va[i].w = __uint_as_float(ua.y & 0xffff0000u);
      vb[i].x = __uint_as_float(ub.x << 16); vb[i].y = __uint_as_float(ub.x & 0xffff0000u); vb[i].z = __uint_as_float(ub.y << 16); vb[i].w = __uint_as_float(ub.y & 0xffff0000u);
    }
#pragma unroll
    for (int i = 0; i < 4; ++i) {
      sa += va[i].x * va[i].x + va[i].y * va[i].y + va[i].z * va[i].z + va[i].w * va[i].w;
      sb += vb[i].x * vb[i].x + vb[i].y * vb[i].y + vb[i].z * vb[i].z + vb[i].w * vb[i].w;
    }
    sa = wsum(sa); sb = wsum(sb);
    const float ra = rsqrtf(sa * (1.f / 1024.f) + 1e-6f), rb = rsqrtf(sb * (1.f / 1024.f) + 1e-6f);
#pragma unroll
    for (int i = 0; i < 4; ++i) {
      const int n = lane * 4 + 256 * i;
      const float4 gg = gg4[i];
      float4 o; o.x = va[i].x * ra * gg.x; o.y = va[i].y * ra * gg.y; o.z = va[i].z * ra * gg.z; o.w = va[i].w * ra * gg.w;
      *(float4*)(ya + n) = o;
      o.x = vb[i].x * rb * gg.x; o.y = vb[i].y * rb * gg.y; o.z = vb[i].z * rb * gg.z; o.w = vb[i].w * rb * gg.w;
      *(float4*)(yb + n) = o;
    }
  }
}

template <int PH>
DI void run_phase(const Params& p, int l, char* smem) {
  if (PH == 0) phase0(p, smem);
  else if (PH == 1) phaseA(p, l);
  else if (PH == 2) phaseB(p, l, smem);
  else if (PH == 3) phaseC(p, l, smem);
  else if (PH == 4) phaseD(p, l, smem);
  else if (PH == 5) phaseE(p, l, smem);
  else if (PH == 6) phaseF(p, l, smem);
  else if (PH == 7) phaseG(p, l);
  else if (PH == 8) phaseH(p, smem);
  else if (PH == 9) phaseI(p, l, smem);
  else phaseZ(p);
}

typedef const Params __attribute__((address_space(4)))* KArgP;
DI KArgP kargs() { KArgP q = (KArgP)__builtin_amdgcn_kernarg_segment_ptr(); asm volatile("" : "+s"(q)); return q; }
#define RUN(PH, L) do { const Params pl_ = *kargs(); run_phase<PH>(pl_, (L), smem); } while (0)

DI void grid_barrier(char* smem) {
  XcdBarrier b;
  b.bar = (unsigned*)(kargs()->ws + OFF_BAR); b.x = xb_xcc_id(); b.st = (volatile LAS unsigned*)(smem + 131080);
  xcd_barrier(b);
}

__global__ void __launch_bounds__(NT, 2) mega_kernel(Params p) {
#if defined(__HIP_DEVICE_COMPILE__)
  __shared__ __attribute__((aligned(16))) char smem[SMEM_BYTES];
  cg::grid_group grid = cg::this_grid();
  if (threadIdx.x == 0) { *(volatile unsigned*)(smem + 131080) = 0u; *(volatile unsigned*)(smem + 131084) = 0u; }
  __syncthreads();
  (void)xcd_barrier_post((unsigned*)(p.ws + OFF_BAR), (volatile LAS unsigned*)(smem + 131080));
  if (p.ws == nullptr) grid.sync();
  RUN(0, 0); grid_barrier(smem);
  for (int l = 0; l < 2; ++l) {
    RUN(1, l); grid_barrier(smem);
    RUN(2, l); grid_barrier(smem);
    RUN(3, l); grid_barrier(smem);
    RUN(4, l); grid_barrier(smem);
    RUN(5, l); grid_barrier(smem);
    RUN(6, l); grid_barrier(smem);
    RUN(7, l); grid_barrier(smem);
    RUN(8, l); grid_barrier(smem);
    RUN(9, l); grid_barrier(smem);
  }
  RUN(10, 0);
#endif
}

extern "C" void kernel_launch(void* const* d_in, const int* in_sizes, int n_in, void* d_out, int out_size, void* d_ws, size_t ws_size, hipStream_t stream) {
  Params p{};
  for (int i = 0; i < 27; ++i) p.in[i] = (const float*)d_in[i];
  p.out = (float*)d_out;
  p.ws = (char*)d_ws;
  if (ws_size < OFF_END) { fprintf(stderr, "workspace too small: %zu < %zu\n", ws_size, (size_t)OFF_END); return; }
  (void)hipMemsetAsync(d_ws, 0, 16384, stream);
  static int grid_blocks = 0;
  if (!grid_blocks) {
    int dev = 0, cus = 0, per_cu = 0;
    (void)hipGetDevice(&dev);
    (void)hipDeviceGetAttribute(&cus, hipDeviceAttributeMultiprocessorCount, dev);
    (void)hipOccupancyMaxActiveBlocksPerMultiprocessor(&per_cu, mega_kernel, NT, 0);
    if (per_cu > 1) per_cu = 1;
    grid_blocks = cus * per_cu;
  }
  void* args[] = {&p};
  hipError_t e = hipLaunchCooperativeKernel((void*)mega_kernel, dim3(grid_blocks), dim3(NT), args, 0, stream);
  if (e != hipSuccess) fprintf(stderr, "cooperative launch failed: %s (grid %d)\n", hipGetErrorString(e), grid_blocks);
}
```
